# Optimizing an MI355X kernel written in HIP

```python
import math, functools
import jax, jax.numpy as jnp
from jax import lax
import numpy as np

D_MODEL = 1024
BATCH = 8
SEQ = 2048
DEPTH = 2
DEC_BATCH = 128
DEC_SEQ = 4
PAST_LEN = 16384
PAGE_SIZE = 128

HEAD_DIM = 64
N_HEADS = D_MODEL // 128
N_KV_HEADS = 2
Q_GROUP = N_HEADS // N_KV_HEADS
WINDOW = 128
ATTN_WIDTH = N_HEADS * HEAD_DIM
KV_WIDTH = N_KV_HEADS * HEAD_DIM
SSM_WIDTH = D_MODEL // 2
GROUP_CH = 16
SSM_GROUPS = SSM_WIDTH // GROUP_CH
SSM_STATE = 64
D_FF = 4 * D_MODEL
IN_COLS = ATTN_WIDTH + 2 * KV_WIDTH + SSM_WIDTH + 2 * D_MODEL
EPS = 1e-6
DT_MIN = 0.001
DT_MAX = 0.1
NEG_INF = -1e30

kernel_name = "gated_s5_swa_sink_hybrid_step"


def _rmsnorm(x, g):
    xf = x.astype(jnp.float32)
    y = xf * lax.rsqrt(jnp.mean(xf * xf, axis=-1, keepdims=True) + EPS) * g.astype(jnp.float32)
    return y.astype(x.dtype)


def _attend(q, k, v, q_pos, k_pos, sinks):
    b, n, nq = q.shape[:3]
    qg = q.reshape(b, n, nq, N_KV_HEADS, Q_GROUP, HEAD_DIM)
    s = jnp.einsum('bnqkgd,bnskd->bnkgqs', qg, k, preferred_element_type=jnp.float32) * (HEAD_DIM ** -0.5)
    dist = q_pos[:, :, None] - k_pos[:, None, :]
    valid = (dist >= 0) & (dist <= WINDOW) & (k_pos >= 0)[:, None, :]
    slopes = jnp.exp2(-8.0 * jnp.arange(1, N_HEADS + 1, dtype=jnp.float32) / N_HEADS).reshape(N_KV_HEADS, Q_GROUP)
    s = s - slopes[None, :, :, None, None] * dist.astype(jnp.float32)[:, None, None]
    s = jnp.where(valid[:, None, None], s, NEG_INF)
    sink = sinks.astype(jnp.float32).reshape(N_KV_HEADS, Q_GROUP)[None, None, :, :, None, None]
    m = jnp.maximum(s.max(axis=-1, keepdims=True), sink)
    e = jnp.exp(s - m)
    p = e / (e.sum(axis=-1, keepdims=True) + jnp.exp(sink - m))
    o = jnp.einsum('bnkgqs,bnskd->bnqkgd', p.astype(v.dtype), v)
    return o.reshape(b, n, nq, ATTN_WIDTH)


def _prompt_attention(q, k, v, sinks):
    b, t = q.shape[:2]
    nb = t // WINDOW
    qb = q.reshape(b, nb, WINDOW, N_HEADS, HEAD_DIM)
    pad = jnp.zeros((b, WINDOW, N_KV_HEADS, HEAD_DIM), k.dtype)

    def bands(a):
        ap = jnp.concatenate([pad, a], axis=1)
        prev = ap[:, :-WINDOW].reshape(b, nb, WINDOW, N_KV_HEADS, HEAD_DIM)
        cur = ap[:, WINDOW:].reshape(b, nb, WINDOW, N_KV_HEADS, HEAD_DIM)
        return jnp.concatenate([prev, cur], axis=2)

    q_pos = jnp.arange(t).reshape(nb, WINDOW)
    k_pos = jnp.arange(nb)[:, None] * WINDOW - WINDOW + jnp.arange(2 * WINDOW)[None, :]
    out = _attend(qb, bands(k), bands(v), q_pos, k_pos, sinks).reshape(b, t, ATTN_WIDTH)
    rows = min(WINDOW, t)
    return out, k[:, t - rows:], v[:, t - rows:]


def _sample_attention(cache_k, cache_v, q, k, v, sinks):
    past = cache_k.shape[1]
    t = q.shape[1]
    kc = jnp.concatenate([cache_k.astype(k.dtype), k], axis=1)
    vc = jnp.concatenate([cache_v.astype(v.dtype), v], axis=1)
    k_pos = PAST_LEN - past + jnp.arange(past + t)
    q_pos = PAST_LEN + jnp.arange(t)
    out = _attend(q[:, None], kc[:, None], vc[:, None], q_pos[None], k_pos[None], sinks)[:, 0]
    return out, kc[:, -past:], vc[:, -past:]


def _combine(e1, e2):
    ar1, ai1, br1, bi1 = e1
    ar2, ai2, br2, bi2 = e2
    return (ar1 * ar2 - ai1 * ai2,
            ar1 * ai2 + ai1 * ar2,
            ar2 * br1 - ai2 * bi1 + br2,
            ar2 * bi1 + ai2 * br1 + bi2)


def _s5_branch(u, h0_re, h0_im, p):
    f32 = jnp.float32
    b, t, _ = u.shape
    uf = u.astype(f32).reshape(b, t, SSM_GROUPS, GROUP_CH)
    lam_re = p['lam_re'].astype(f32)
    lam_im = p['lam_im'].astype(f32)
    step = jnp.exp(p['log_step'].astype(f32))[:, None]
    mag = jnp.exp(lam_re * step)
    ar = mag * jnp.cos(lam_im * step)
    ai = mag * jnp.sin(lam_im * step)
    den = lam_re * lam_re + lam_im * lam_im
    cr = ((ar - 1.0) * lam_re + ai * lam_im) / den
    ci = (ai * lam_re - (ar - 1.0) * lam_im) / den
    b_re = p['b_re'].astype(f32)
    b_im = p['b_im'].astype(f32)
    bb_re = cr[..., None] * b_re - ci[..., None] * b_im
    bb_im = cr[..., None] * b_im + ci[..., None] * b_re
    x_re = jnp.einsum('bsgc,gpc->sbgp', uf, bb_re)
    x_im = jnp.einsum('bsgc,gpc->sbgp', uf, bb_im)
    h0r = h0_re.astype(f32)
    h0i = h0_im.astype(f32)
    x_re = x_re.at[0].add(ar * h0r - ai * h0i)
    x_im = x_im.at[0].add(ar * h0i + ai * h0r)
    a_re = jnp.broadcast_to(ar, x_re.shape)
    a_im = jnp.broadcast_to(ai, x_im.shape)
    _, _, h_re, h_im = lax.associative_scan(_combine, (a_re, a_im, x_re, x_im), axis=0)
    y = (jnp.einsum('sbgp,gcp->bsgc', h_re, p['c_re'].astype(f32))
         - jnp.einsum('sbgp,gcp->bsgc', h_im, p['c_im'].astype(f32)))
    y = y.reshape(b, t, SSM_WIDTH) + p['d_skip'].astype(f32) * uf.reshape(b, t, SSM_WIDTH)
    y = jax.nn.gelu(y).astype(u.dtype)
    y = y * jax.nn.sigmoid(y @ p['w_glu'] + p['b_glu'])
    return y, h_re[-1], h_im[-1]


def _layer(x, attn_fn, h0_re, h0_im, p):
    b, t, _ = x.shape
    z = _rmsnorm(x, p['norm1_g']) @ p['w_in']
    o1 = ATTN_WIDTH
    o2 = o1 + KV_WIDTH
    o3 = o2 + KV_WIDTH
    o4 = o3 + SSM_WIDTH
    q, k, v, u, g = jnp.split(z, [o1, o2, o3, o4], axis=-1)
    q = _rmsnorm(q.reshape(b, t, N_HEADS, HEAD_DIM), p['q_norm_g'])
    k = _rmsnorm(k.reshape(b, t, N_KV_HEADS, HEAD_DIM), p['k_norm_g'])
    v = v.reshape(b, t, N_KV_HEADS, HEAD_DIM)
    attn, k_state, v_state = attn_fn(q, k, v, p['attn_sinks'])
    ssm, h_re, h_im = _s5_branch(u, h0_re, h0_im, p)
    gates = jax.nn.sigmoid((g + p['b_gate']).astype(jnp.float32)).astype(x.dtype)
    g_attn, g_ssm = jnp.split(gates, 2, axis=-1)
    mixed = g_attn * (attn @ p['w_attn_o']) + g_ssm * (ssm @ p['w_ssm_o'])
    x = x + mixed @ p['w_out']
    hdn = jax.nn.relu(_rmsnorm(x, p['norm2_g']) @ p['w_up'])
    x = x + (hdn * hdn) @ p['w_down']
    return x, k_state, v_state, h_re, h_im


def setup_inputs(seed: int = 0) -> dict:
    key = jax.random.key(seed)
    ks = jax.random.split(key, 32)
    f32 = jnp.float32
    nrm = lambda k, shape, s: jax.random.normal(k, shape, f32) * s
    rows = min(WINDOW, PAST_LEN)
    L, G, P, GC = DEPTH, SSM_GROUPS, SSM_STATE, GROUP_CH
    n_idx = jnp.arange(P, dtype=f32)
    return {
        'x_prompt': nrm(ks[0], (BATCH, SEQ, D_MODEL), 1.0),
        'x_sample': nrm(ks[1], (DEC_BATCH, DEC_SEQ, D_MODEL), 1.0),
        'cache_k': nrm(ks[2], (L, DEC_BATCH, rows, N_KV_HEADS, HEAD_DIM), 1.0),
        'cache_v': nrm(ks[3], (L, DEC_BATCH, rows, N_KV_HEADS, HEAD_DIM), 1.0),
        'state_ssm_re': nrm(ks[4], (L, DEC_BATCH, G, P), 0.5),
        'state_ssm_im': nrm(ks[5], (L, DEC_BATCH, G, P), 0.5),
        'norm1_g': 1.0 + nrm(ks[6], (L, D_MODEL), 0.02),
        'w_in': nrm(ks[7], (L, D_MODEL, IN_COLS), D_MODEL ** -0.5),
        'b_gate': nrm(ks[8], (L, 2 * D_MODEL), 0.01),
        'q_norm_g': 1.0 + nrm(ks[9], (L, HEAD_DIM), 0.02),
        'k_norm_g': 1.0 + nrm(ks[10], (L, HEAD_DIM), 0.02),
        'attn_sinks': nrm(ks[11], (L, N_HEADS), 0.5),
        'lam_re': -0.5 + nrm(ks[12], (L, G, P), 0.01),
        'lam_im': math.pi * n_idx + nrm(ks[13], (L, G, P), 0.01),
        'log_step': jax.random.uniform(ks[14], (L, G), f32, math.log(DT_MIN), math.log(DT_MAX)),
        'b_re': nrm(ks[15], (L, G, P, GC), (2 * GC) ** -0.5),
        'b_im': nrm(ks[16], (L, G, P, GC), (2 * GC) ** -0.5),
        'c_re': nrm(ks[17], (L, G, GC, P), P ** -0.5),
        'c_im': nrm(ks[18], (L, G, GC, P), P ** -0.5),
        'd_skip': nrm(ks[19], (L, SSM_WIDTH), 1.0),
        'w_glu': nrm(ks[20], (L, SSM_WIDTH, SSM_WIDTH), SSM_WIDTH ** -0.5),
        'b_glu': nrm(ks[21], (L, SSM_WIDTH), 0.01),
        'w_attn_o': nrm(ks[22], (L, ATTN_WIDTH, D_MODEL), ATTN_WIDTH ** -0.5),
        'w_ssm_o': nrm(ks[23], (L, SSM_WIDTH, D_MODEL), SSM_WIDTH ** -0.5),
        'w_out': nrm(ks[24], (L, D_MODEL, D_MODEL), D_MODEL ** -0.5),
        'norm2_g': 1.0 + nrm(ks[25], (L, D_MODEL), 0.02),
        'w_up': nrm(ks[26], (L, D_MODEL, D_FF), D_MODEL ** -0.5),
        'w_down': nrm(ks[27], (L, D_FF, D_MODEL), D_FF ** -0.5),
    }


def reference(x_prompt, x_sample, cache_k, cache_v, state_ssm_re, state_ssm_im,
              norm1_g, w_in, b_gate, q_norm_g, k_norm_g, attn_sinks,
              lam_re, lam_im, log_step, b_re, b_im, c_re, c_im, d_skip, w_glu, b_glu,
              w_attn_o, w_ssm_o, w_out, norm2_g, w_up, w_down):
    yp, ys = x_prompt, x_sample
    kp_l, vp_l, hrp_l, hip_l = [], [], [], []
    ks_l, vs_l, hrs_l, his_l = [], [], [], []
    sdt = state_ssm_re.dtype
    for l in range(DEPTH):
        p = {'norm1_g': norm1_g[l], 'w_in': w_in[l], 'b_gate': b_gate[l],
             'q_norm_g': q_norm_g[l], 'k_norm_g': k_norm_g[l], 'attn_sinks': attn_sinks[l],
             'lam_re': lam_re[l], 'lam_im': lam_im[l], 'log_step': log_step[l],
             'b_re': b_re[l], 'b_im': b_im[l], 'c_re': c_re[l], 'c_im': c_im[l],
             'd_skip': d_skip[l], 'w_glu': w_glu[l], 'b_glu': b_glu[l],
             'w_attn_o': w_attn_o[l], 'w_ssm_o': w_ssm_o[l], 'w_out': w_out[l],
             'norm2_g': norm2_g[l], 'w_up': w_up[l], 'w_down': w_down[l]}
        h0 = jnp.zeros((yp.shape[0], SSM_GROUPS, SSM_STATE), jnp.float32)
        yp, kp, vp, hrp, hip = _layer(yp, _prompt_attention, h0, h0, p)
        ys, kss, vss, hrs, his = _layer(
            ys, functools.partial(_sample_attention, cache_k[l], cache_v[l]),
            state_ssm_re[l], state_ssm_im[l], p)
        kp_l.append(kp); vp_l.append(vp); hrp_l.append(hrp.astype(sdt)); hip_l.append(hip.astype(sdt))
        ks_l.append(kss); vs_l.append(vss); hrs_l.append(hrs.astype(sdt)); his_l.append(his.astype(sdt))
    k_prompt = jnp.stack(kp_l)
    v_prompt = jnp.stack(vp_l)
    ssm_re_prompt = jnp.stack(hrp_l)
    ssm_im_prompt = jnp.stack(hip_l)
    k_sample = jnp.stack(ks_l)
    v_sample = jnp.stack(vs_l)
    ssm_re_sample = jnp.stack(hrs_l)
    ssm_im_sample = jnp.stack(his_l)
    return (yp, ys, k_prompt, v_prompt, ssm_re_prompt, ssm_im_prompt,
            k_sample, v_sample, ssm_re_sample, ssm_im_sample)
```

```cpp
#include <hip/hip_runtime.h>
#include <hip/hip_cooperative_groups.h>
#include <cstdio>
#include <cstdint>
namespace cg = cooperative_groups;
namespace pg8 {
#define PG8_LAS __attribute__((address_space(3)))
typedef unsigned short bf16_t;
typedef short bf16x8 __attribute__((ext_vector_type(8)));
typedef float f32x4 __attribute__((ext_vector_type(4)));
typedef unsigned u32x4 __attribute__((ext_vector_type(4)));
constexpr int BM = 256, BK = 64, HALF = 128, HTB = HALF * BK * 2  , STAGE_BYTES = 8 * HTB, NXCD = 8, WGM = 8;

__host__ __device__ __forceinline__ int lds_byte(int r, int c) { const int st = (r >> 4) * 2 + (c >> 5), rr = r & 15, cc = c & 31, ob = rr * 64 + cc * 2; return st * 1024 + (ob ^ (((ob >> 9) & 1) << 5)); }
__host__ __device__ __forceinline__ void stage_rc(int b, int& R, int& C) { const int st = b / 1024, sb = b % 1024, swz = sb ^ (((sb >> 9) & 1) << 5); R = (st >> 1) * 16 + swz / 64; C = (st & 1) * 32 + (swz % 64) / 2; }
__host__ __device__ __forceinline__ int perm32(int rho) { const int n = rho >> 4, i = rho & 15; return 8 * (i >> 2) + 4 * n + (i & 3); }

struct Unit { int pm, pn; };
struct Gemm { const bf16_t* A; const bf16_t* Bt; int M, N, K; };

struct StaticOrder {
    int nM, nN, nwg, G, c;
    __host__ __device__ void init(int M, int N, int G_, int c_) { nM = M / BM; nN = N / BM; nwg = nM * nN; G = G_; c = c_; }
    __host__ __device__ bool next(int i, Unit& u) const {
        const long L = (long)i * G + c; if (L >= nwg) return false;
        int wgid = (int)L; { const int q = nwg / NXCD, r = nwg % NXCD, xcd = wgid % NXCD, off = wgid / NXCD; wgid = (xcd < r ? xcd * (q + 1) : r * (q + 1) + (xcd - r) * q) + off; }
        const int nig = WGM * nN, gid = wgid / nig, fm = gid * WGM, gsz = (nM - fm) < WGM ? (nM - fm) : WGM;
        u.pm = fm + ((wgid % nig) % gsz); u.pn = (wgid % nig) / gsz; return true;
    }
    __device__ __forceinline__ void a_ready(const Unit&) const {}
    __device__ __forceinline__ void done(const Unit&) const {}
};
__device__ __forceinline__ unsigned cvt_pk_bf16(float lo, float hi) { unsigned r; asm volatile("v_cvt_pk_bf16_f32 %0, %1, %2" : "=v"(r) : "v"(lo), "v"(hi)); return r; }
typedef float f32x2 __attribute__((ext_vector_type(2)));
template <class Epi, class Sched, bool ALIGN_EPI = false, bool SP2 = false>
__device__ __forceinline__ void gemm_phase(PG8_LAS unsigned char* lds, const Gemm g, const Sched& S, const Epi& E) {
    int tid_ = threadIdx.x; asm volatile("" : "+v"(tid_));
    const int tid = tid_, wid = __builtin_amdgcn_readfirstlane(tid >> 6), lane = tid & 63, wr = wid >> 2, wc = wid & 3, fr = lane & 15, fq = lane >> 4;
    const int K = g.K, nt = K / BK;
    unsigned voffA[2], voffB[2];
#pragma unroll
    for (int i = 0; i < 2; ++i) { int R, C; stage_rc(tid * 16 + i * 8192, R, C); const int Rb = Epi::PERM ? ((R & ~31) + perm32(R & 31)) : R;
        voffA[i] = (unsigned)(R * K + C) * 2u; voffB[i] = (unsigned)(Rb * K + C) * 2u; }
    const size_t kstep = (size_t)(BK * 2);
    const size_t hstep = (size_t)HALF * K * 2;
    const size_t tstep = 2 * hstep;
    const unsigned ldsw = (unsigned)wid * 1024u;
    const int aoff = lds_byte(wr * 64 + fr, fq * 8), boff = lds_byte(wc * 32 + fr, fq * 8);
#define PG8_SA(b, h) (((b) * 2 + (h)) * HTB)
#define PG8_SB(b, h) ((4 + (b) * 2 + (h)) * HTB)
#define PG8_STAGE(bufoff, gbase, voff) do { _Pragma("unroll") for (int _i = 0; _i < 2; ++_i) \
        __builtin_amdgcn_global_load_lds((const unsigned*)((const char*)(gbase) + (voff)[_i]), (PG8_LAS unsigned*)(lds + (bufoff) + ldsw + _i * 8192), 16, 0, 0); } while (0)
#define PG8_LDA(dst, b, h) do { _Pragma("unroll") for (int m = 0; m < 4; ++m) _Pragma("unroll") for (int k = 0; k < 2; ++k) dst[m][k] = *(const PG8_LAS bf16x8*)(lds + PG8_SA(b, h) + aoff + m * 2048 + k * 1024); } while (0)
#define PG8_LDB(dst, b, h) do { _Pragma("unroll") for (int n = 0; n < 2; ++n) _Pragma("unroll") for (int k = 0; k < 2; ++k) dst[n][k] = *(const PG8_LAS bf16x8*)(lds + PG8_SB(b, h) + boff + n * 2048 + k * 1024); } while (0)
#define PG8_MMA(ai, bj, At, Bt) do { __builtin_amdgcn_s_setprio(1); _Pragma("unroll") for (int m = 0; m < 4; ++m) _Pragma("unroll") for (int n = 0; n < 2; ++n) _Pragma("unroll") for (int k = 0; k < 2; ++k) \
        acc[ai][bj][m][n] = __builtin_amdgcn_mfma_f32_16x16x32_bf16(Bt[n][k], At[m][k], acc[ai][bj][m][n], 0, 0, 0); __builtin_amdgcn_s_setprio(0); } while (0)
#define PG8_WAIT_V(n) asm volatile("s_waitcnt vmcnt(" #n ")" ::: "memory")
#define PG8_WAIT_L(n) asm volatile("s_waitcnt lgkmcnt(" #n ")" ::: "memory")
#define PG8_BAR __builtin_amdgcn_s_barrier()
#define PG8_SCHED __builtin_amdgcn_sched_barrier(0)
    Unit cur, nxt; int ui = 0;
    if (!S.next(0, cur)) return;
    f32x4 acc[2][2][4][2];
#pragma unroll
    for (int a = 0; a < 2; ++a)
#pragma unroll
        for (int b = 0; b < 2; ++b)
#pragma unroll
            for (int m = 0; m < 4; ++m)
#pragma unroll
                for (int n = 0; n < 2; ++n) acc[a][b][m][n] = (f32x4){0.f, 0.f, 0.f, 0.f};
    bf16x8 At[4][2], B0[2][2], B1[2][2];
    const char* cA = (const char*)g.A + (size_t)cur.pm * tstep; const char* cB = (const char*)g.Bt + (size_t)cur.pn * tstep;
    S.a_ready(cur);
    if constexpr (SP2) {
        PG8_STAGE(PG8_SB(0, 0), cB, voffB); PG8_STAGE(PG8_SB(0, 1), cB + hstep, voffB); PG8_STAGE(PG8_SA(0, 0), cA, voffA); PG8_STAGE(PG8_SA(0, 1), cA + hstep, voffA);
        if (wr == 1) PG8_BAR;
        PG8_WAIT_V(2); PG8_BAR;
        PG8_STAGE(PG8_SB(1, 0), cB + kstep, voffB); PG8_STAGE(PG8_SA(1, 0), cA + kstep, voffA); PG8_STAGE(PG8_SB(1, 1), cB + hstep + kstep, voffB);
        PG8_WAIT_V(6); PG8_BAR;
    } else {
        PG8_STAGE(PG8_SB(0, 0), cB, voffB); PG8_STAGE(PG8_SA(0, 0), cA, voffA); PG8_STAGE(PG8_SB(0, 1), cB + hstep, voffB); PG8_STAGE(PG8_SA(0, 1), cA + hstep, voffA);
        if (wr == 1) PG8_BAR;
        PG8_WAIT_V(4); PG8_BAR;
        PG8_STAGE(PG8_SB(1, 0), cB + kstep, voffB); PG8_STAGE(PG8_SA(1, 0), cA + kstep, voffA); PG8_STAGE(PG8_SB(1, 1), cB + hstep + kstep, voffB);
        PG8_WAIT_V(6); PG8_BAR;
    }
    for (;;) {
        const bool has_next = S.next(ui + 1, nxt);
        const char* nA = has_next ? (const char*)g.A + (size_t)nxt.pm * tstep : cA; const char* nB = has_next ? (const char*)g.Bt + (size_t)nxt.pn * tstep : cB;
        for (int t = 0; t < nt; t += 2) {
            const bool last = (t == nt - 2);
            const char* a1 = cA + (size_t)(t + 1) * kstep;
            const char* a2 = last ? nA : cA + (size_t)(t + 2) * kstep; const char* b2 = last ? nB : cB + (size_t)(t + 2) * kstep;
            const char* a3 = a2 + kstep; const char* b3 = b2 + kstep;
            if (last && has_next) S.a_ready(nxt);
            if constexpr (SP2) {
            PG8_LDB(B0, 0, 0); PG8_LDB(B1, 0, 1); PG8_SCHED; PG8_LDA(At, 0, 0); PG8_STAGE(PG8_SA(1, 1), a1 + hstep, voffA);
            PG8_WAIT_V(8); PG8_WAIT_L(0); PG8_BAR; PG8_MMA(0, 0, At, B0); PG8_MMA(0, 1, At, B1); PG8_BAR; PG8_SCHED;
            PG8_LDA(At, 0, 1); PG8_STAGE(PG8_SB(0, 0), b2, voffB); PG8_STAGE(PG8_SB(0, 1), b2 + hstep, voffB); PG8_STAGE(PG8_SA(0, 0), a2, voffA);
            PG8_WAIT_V(8); PG8_WAIT_L(0); PG8_BAR; PG8_MMA(1, 0, At, B0); PG8_MMA(1, 1, At, B1); PG8_BAR; PG8_SCHED;
            PG8_LDB(B0, 1, 0); PG8_LDB(B1, 1, 1); PG8_SCHED; PG8_LDA(At, 1, 0); PG8_STAGE(PG8_SA(0, 1), a2 + hstep, voffA);
            PG8_WAIT_V(8); PG8_WAIT_L(0); PG8_BAR; PG8_MMA(0, 0, At, B0); PG8_MMA(0, 1, At, B1); PG8_BAR; PG8_SCHED;
            PG8_LDA(At, 1, 1); PG8_STAGE(PG8_SB(1, 0), b3, voffB); PG8_STAGE(PG8_SB(1, 1), b3 + hstep, voffB); PG8_STAGE(PG8_SA(1, 0), a3, voffA);
            PG8_WAIT_V(8); PG8_WAIT_L(0); PG8_BAR; PG8_MMA(1, 0, At, B0); PG8_MMA(1, 1, At, B1); PG8_BAR; PG8_SCHED;
            } else {
            PG8_LDB(B0, 0, 0); PG8_SCHED; PG8_LDA(At, 0, 0); PG8_STAGE(PG8_SA(1, 1), a1 + hstep, voffA);
            PG8_WAIT_L(8); PG8_BAR; PG8_WAIT_L(0); PG8_MMA(0, 0, At, B0); PG8_BAR; PG8_SCHED;
            PG8_LDB(B1, 0, 1); PG8_STAGE(PG8_SB(0, 0), b2, voffB);
            PG8_BAR; PG8_WAIT_L(0); PG8_MMA(0, 1, At, B1); PG8_BAR;
            PG8_LDA(At, 0, 1); PG8_STAGE(PG8_SA(0, 0), a2, voffA);
            PG8_BAR; PG8_WAIT_L(0); PG8_MMA(1, 0, At, B0); PG8_BAR; PG8_SCHED;
            PG8_STAGE(PG8_SB(0, 1), b2 + hstep, voffB);
            PG8_WAIT_V(6); PG8_BAR; PG8_MMA(1, 1, At, B1); PG8_BAR;
            PG8_LDB(B0, 1, 0); PG8_SCHED; PG8_LDA(At, 1, 0); PG8_STAGE(PG8_SA(0, 1), a2 + hstep, voffA);
            PG8_WAIT_L(8); PG8_BAR; PG8_WAIT_L(0); PG8_MMA(0, 0, At, B0); PG8_BAR; PG8_SCHED;
            PG8_LDB(B1, 1, 1); PG8_STAGE(PG8_SB(1, 0), b3, voffB);
            PG8_BAR; PG8_WAIT_L(0); PG8_MMA(0, 1, At, B1); PG8_BAR;
            PG8_LDA(At, 1, 1); PG8_STAGE(PG8_SA(1, 0), a3, voffA);
            PG8_BAR; PG8_WAIT_L(0); PG8_MMA(1, 0, At, B0); PG8_BAR; PG8_SCHED;
            PG8_STAGE(PG8_SB(1, 1), b3 + hstep, voffB);
            PG8_WAIT_V(6); PG8_BAR; PG8_MMA(1, 1, At, B1); PG8_BAR;
            }
        }
        if constexpr (ALIGN_EPI) { if (wr == 0) PG8_BAR; }
        if constexpr (!Epi::AFTER_DRAIN) { E(acc, cur, wr, wc, fr, fq); S.done(cur); }
        if (!has_next) break;
#pragma unroll
        for (int a = 0; a < 2; ++a)
#pragma unroll
            for (int b = 0; b < 2; ++b)
#pragma unroll
                for (int m = 0; m < 4; ++m)
#pragma unroll
                    for (int n = 0; n < 2; ++n) acc[a][b][m][n] = (f32x4){0.f, 0.f, 0.f, 0.f};
        cur = nxt; cA = nA; cB = nB; ++ui;
        if constexpr (ALIGN_EPI) { if (wr == 1) PG8_BAR; }
    }
    PG8_WAIT_V(0);
    if constexpr (!ALIGN_EPI) { if (wr == 0) PG8_BAR; }
    PG8_BAR;
    if constexpr (Epi::AFTER_DRAIN) { E.fused(acc, cur, wr, wc, fr, fq, lds, wid, lane); S.done(cur); }
#undef PG8_SA
#undef PG8_SB
#undef PG8_STAGE
#undef PG8_LDA
#undef PG8_LDB
#undef PG8_MMA
#undef PG8_WAIT_V
#undef PG8_WAIT_L
#undef PG8_BAR
#undef PG8_SCHED
}
}
using pg8::bf16_t; using pg8::bf16x8; using pg8::f32x4; using pg8::u32x4; using pg8::Unit;
#define LAS __attribute__((address_space(3)))
typedef unsigned u32x2 __attribute__((ext_vector_type(2)));

constexpr int DM = 1024, SEQ = 2048, NBATCH = 8, DEC_B = 128, DEC_T = 4, WIN = 128;
constexpr int NTOK_P = NBATCH * SEQ, NTOK_S = DEC_B * DEC_T, MTOK = NTOK_P + NTOK_S;
constexpr int INC = 3328, FF = 4096, NG = 32, NP = 64, GC = 16;
constexpr int ZQ = 0, ZK = 512, ZV = 640, ZU = 768, ZG = 1280;
constexpr int SBLK = 64, SEGB = 4, NSEG = SEQ / (SBLK * SEGB);
constexpr float EPS = 1e-6f, LOG2E = 1.4426950408889634f;
constexpr size_t MiB = 1u << 20;
constexpr size_t WS_SS = 1 * MiB, WS_TA = 1 * MiB + 512 * 1024, WS_TC = 1 * MiB + 640 * 1024, WS_TB = 2 * MiB;
constexpr size_t WS_W = 3 * MiB, WS_A = 57 * MiB, WS_B = 90 * MiB, WS_C = 123 * MiB, WS_END = 255 * MiB;
constexpr size_t W_IN = 0, W_GLU = W_IN + (size_t)INC * DM, W_AO = W_GLU + 512 * 512, W_SO = W_AO + 1024 * 512, W_OUT = W_SO + 1024 * 512,
                 W_UP = W_OUT + 1024 * 1024, W_DN = W_UP + (size_t)FF * DM, W_LAYER = W_DN + (size_t)FF * DM;
static_assert(WS_W + 2 * W_LAYER * 2 <= WS_A, "weights fit");
constexpr size_t HALFROWS = (size_t)MTOK * 512 * 2;
constexpr size_t ZBYTES = (size_t)MTOK * INC * 2;
static_assert(ZBYTES + HALFROWS + 4 * MiB <= WS_END - WS_C && (size_t)MTOK * FF * 2 <= WS_END - WS_C, "region C");
constexpr size_t O_YP = 0, O_YS = (size_t)NTOK_P * DM, O_KP = O_YS + (size_t)NTOK_S * DM, O_VP = O_KP + 2 * 8 * 128 * 128, O_HRP = O_VP + 2 * 8 * 128 * 128,
                 O_HIP = O_HRP + 2 * 8 * 32 * 64, O_KS = O_HIP + 2 * 8 * 32 * 64, O_VS = O_KS + (size_t)2 * 128 * 128 * 128, O_HRS = O_VS + (size_t)2 * 128 * 128 * 128,
                 O_HIS = O_HRS + 2 * 128 * 32 * 64, O_END = O_HIS + 2 * 128 * 32 * 64;
constexpr int LDS_BYTES = 147456;

__device__ __forceinline__ float bf2f(unsigned short b) { return __uint_as_float(((unsigned)b) << 16); }
__device__ __forceinline__ float bflo(unsigned w) { return __uint_as_float(w << 16); }
__device__ __forceinline__ float bfhi(unsigned w) { return __uint_as_float(w & 0xffff0000u); }
__device__ __forceinline__ unsigned pk2(float lo, float hi) { return pg8::cvt_pk_bf16(lo, hi); }
__device__ __forceinline__ unsigned short f2bf(float f) { return (unsigned short)(pg8::cvt_pk_bf16(f, 0.f) & 0xffffu); }
__device__ __forceinline__ float sigm(float x) { return __builtin_amdgcn_rcpf(1.f + __builtin_amdgcn_exp2f(-LOG2E * x)); }
__device__ __forceinline__ float gelu_tanh(float y) { const float y2 = y * y, t = y * (-2.f * 0.7978845608028654f * LOG2E - (2.f * 0.7978845608028654f * 0.044715f * LOG2E) * y2);
    return y * __builtin_amdgcn_rcpf(1.f + __builtin_amdgcn_exp2f(t)); }
__device__ __forceinline__ void unpack8(const u32x4 w, float (&f)[8]) { f[0] = bflo(w.x); f[1] = bfhi(w.x); f[2] = bflo(w.y); f[3] = bfhi(w.y); f[4] = bflo(w.z); f[5] = bfhi(w.z); f[6] = bflo(w.w); f[7] = bfhi(w.w); }
__device__ __forceinline__ int opq(int v) { asm volatile("" : "+v"(v)); return v; }
__device__ __forceinline__ float wave_sum(float v) {
#pragma unroll
    for (int o = 1; o < 64; o <<= 1) v += __shfl_xor(v, o);
    return v;
}

struct EpiIn {
    static constexpr bool PERM = true, AFTER_DRAIN = false;
    bf16_t* Z; const float* ss; const float* bgate; int pn0;
    struct Pre { float ssv; f32x4 b; };
    __device__ __forceinline__ void prefetch4(int row, int col, Pre& p) const { p.ssv = ss[row]; p.b = col >= ZG ? *(const f32x4*)(bgate + (col - ZG)) : (f32x4){0.f, 0.f, 0.f, 0.f}; }
    __device__ __forceinline__ void apply4(int row, int col, f32x4 v, const Pre& p) const {
        const float rs = rsqrtf(p.ssv * (1.f / DM) + EPS); v = v * rs;
        if (col >= ZG) { const f32x4 b = p.b; v = (f32x4){sigm(v[0] + b[0]), sigm(v[1] + b[1]), sigm(v[2] + b[2]), sigm(v[3] + b[3])}; }
        u32x2 w; w.x = pk2(v[0], v[1]); w.y = pk2(v[2], v[3]); *(u32x2*)(Z + (size_t)row * INC + col) = w;
    }
    __device__ __forceinline__ void operator()(const f32x4 (&acc)[2][2][4][2], const Unit& u, int wr, int wc, int fr, int fq) const {
        const int row0 = u.pm * 256 + wr * 64 + fr, col0 = (u.pn + pn0) * 256 + wc * 32 + 8 * fq; const bool gate = u.pn + pn0 >= 5;
        f32x4 bv[2][2];
#pragma unroll
        for (int bj = 0; bj < 2; ++bj)
#pragma unroll
            for (int n = 0; n < 2; ++n) bv[bj][n] = gate ? *(const f32x4*)(bgate + (col0 - ZG) + bj * 128 + 4 * n) : (f32x4){0.f, 0.f, 0.f, 0.f};
        float rsv[2][4];
#pragma unroll
        for (int ai = 0; ai < 2; ++ai)
#pragma unroll
            for (int m = 0; m < 4; ++m) rsv[ai][m] = ss[row0 + ai * 128 + m * 16];
        __builtin_amdgcn_sched_barrier(0);
#pragma unroll
        for (int ai = 0; ai < 2; ++ai)
#pragma unroll
            for (int m = 0; m < 4; ++m) { const int row = row0 + ai * 128 + m * 16; const float rs = rsqrtf(rsv[ai][m] * (1.f / DM) + EPS); bf16_t* rowp = Z + (size_t)row * INC + col0;
#pragma unroll
                for (int bj = 0; bj < 2; ++bj) { f32x4 v0 = acc[ai][bj][m][0] * rs + bv[bj][0], v1 = acc[ai][bj][m][1] * rs + bv[bj][1];
                    if (gate) { v0 = (f32x4){sigm(v0[0]), sigm(v0[1]), sigm(v0[2]), sigm(v0[3])}; v1 = (f32x4){sigm(v1[0]), sigm(v1[1]), sigm(v1[2]), sigm(v1[3])}; }
                    u32x4 w; w.x = pk2(v0[0], v0[1]); w.y = pk2(v0[2], v0[3]); w.z = pk2(v1[0], v1[1]); w.w = pk2(v1[2], v1[3]);
                    *(u32x4*)(rowp + bj * 128) = w; } }
    }
};
struct EpiGlu {
    static constexpr bool PERM = true, AFTER_DRAIN = false;
    const bf16_t* Y; bf16_t* O; const float* b;
    struct Pre { u32x2 yw; f32x4 bb; };
    __device__ __forceinline__ void prefetch4(int row, int col, Pre& p) const { p.yw = *(const u32x2*)(Y + (size_t)row * 512 + col); p.bb = *(const f32x4*)(b + col); }
    __device__ __forceinline__ void apply4(int row, int col, f32x4 v, const Pre& p) const {
        const u32x2 yw = p.yw; const f32x4 bb = p.bb;
        u32x2 w; w.x = pk2(bflo(yw.x) * sigm(v[0] + bb[0]), bfhi(yw.x) * sigm(v[1] + bb[1])); w.y = pk2(bflo(yw.y) * sigm(v[2] + bb[2]), bfhi(yw.y) * sigm(v[3] + bb[3]));
        *(u32x2*)(O + (size_t)row * 512 + col) = w;
    }
    __device__ __forceinline__ void operator()(const f32x4 (&acc)[2][2][4][2], const Unit& u, int wr, int wc, int fr, int fq) const {
        const int row0 = u.pm * 256 + wr * 64 + fr, col0 = u.pn * 256 + wc * 32 + 8 * fq;
        f32x4 bv[2][2];
#pragma unroll
        for (int bj = 0; bj < 2; ++bj)
#pragma unroll
            for (int n = 0; n < 2; ++n) bv[bj][n] = *(const f32x4*)(b + col0 + bj * 128 + 4 * n);
#pragma unroll
        for (int ai = 0; ai < 2; ++ai) {
            u32x4 yraw[4][2];
#pragma unroll
            for (int m = 0; m < 4; ++m)
#pragma unroll
                for (int bj = 0; bj < 2; ++bj) yraw[m][bj] = *(const u32x4*)(Y + (size_t)(row0 + ai * 128 + m * 16) * 512 + col0 + bj * 128);
            __builtin_amdgcn_sched_barrier(0);
#pragma unroll
            for (int m = 0; m < 4; ++m) { const size_t off = (size_t)(row0 + ai * 128 + m * 16) * 512 + col0;
#pragma unroll
                for (int bj = 0; bj < 2; ++bj) { const f32x4 v0 = acc[ai][bj][m][0] + bv[bj][0], v1 = acc[ai][bj][m][1] + bv[bj][1];
                    float y[8]; unpack8(yraw[m][bj], y);
                    u32x4 w; w.x = pk2(y[0] * sigm(v0[0]), y[1] * sigm(v0[1])); w.y = pk2(y[2] * sigm(v0[2]), y[3] * sigm(v0[3]));
                    w.z = pk2(y[4] * sigm(v1[0]), y[5] * sigm(v1[1])); w.w = pk2(y[6] * sigm(v1[2]), y[7] * sigm(v1[3]));
                    *(u32x4*)(O + off + bj * 128) = w; } } }
    }
};
template <bool SECOND> struct EpiMix {
    static constexpr bool PERM = true, AFTER_DRAIN = false;
    const bf16_t* Zg; bf16_t* O;
    struct Pre { u32x2 gw, pw; };
    __device__ __forceinline__ void prefetch4(int row, int col, Pre& p) const { p.gw = *(const u32x2*)(Zg + (size_t)row * INC + col); if (SECOND) p.pw = *(const u32x2*)(O + (size_t)row * DM + col); }
    __device__ __forceinline__ void apply4(int row, int col, f32x4 v, const Pre& p) const {
        const u32x2 gw = p.gw; bf16_t* op = O + (size_t)row * DM + col;
        v = (f32x4){bflo(gw.x) * v[0], bfhi(gw.x) * v[1], bflo(gw.y) * v[2], bfhi(gw.y) * v[3]};
        if (SECOND) { const u32x2 pw = p.pw; v = v + (f32x4){bflo(pw.x), bfhi(pw.x), bflo(pw.y), bfhi(pw.y)}; }
        u32x2 w; w.x = pk2(v[0], v[1]); w.y = pk2(v[2], v[3]); *(u32x2*)op = w;
    }
    __device__ __forceinline__ void operator()(const f32x4 (&acc)[2][2][4][2], const Unit& u, int wr, int wc, int fr, int fq) const {
        const int row0 = u.pm * 256 + wr * 64 + fr, col0 = u.pn * 256 + wc * 32 + 8 * fq;
#pragma unroll
        for (int ai = 0; ai < 2; ++ai) {
            u32x4 graw[4][2], praw[4][2];
#pragma unroll
            for (int m = 0; m < 4; ++m)
#pragma unroll
                for (int bj = 0; bj < 2; ++bj) { const int row = row0 + ai * 128 + m * 16; graw[m][bj] = *(const u32x4*)(Zg + (size_t)row * INC + col0 + bj * 128);
                    if (SECOND) praw[m][bj] = *(const u32x4*)(O + (size_t)row * DM + col0 + bj * 128); }
            __builtin_amdgcn_sched_barrier(0);
#pragma unroll
            for (int m = 0; m < 4; ++m) { const int row = row0 + ai * 128 + m * 16;
#pragma unroll
                for (int bj = 0; bj < 2; ++bj) { const f32x4 a0 = acc[ai][bj][m][0], a1 = acc[ai][bj][m][1];
                    float g[8]; unpack8(graw[m][bj], g);
                    float v[8] = {g[0] * a0[0], g[1] * a0[1], g[2] * a0[2], g[3] * a0[3], g[4] * a1[0], g[5] * a1[1], g[6] * a1[2], g[7] * a1[3]};
                    bf16_t* op = O + (size_t)row * DM + col0 + bj * 128;
                    if (SECOND) { float p[8]; unpack8(praw[m][bj], p);
#pragma unroll
                        for (int k = 0; k < 8; ++k) v[k] += p[k]; }
                    u32x4 w; w.x = pk2(v[0], v[1]); w.y = pk2(v[2], v[3]); w.z = pk2(v[4], v[5]); w.w = pk2(v[6], v[7]);
                    *(u32x4*)op = w; } } }
    }
};
struct EpiRes {
    static constexpr bool PERM = true, AFTER_DRAIN = false;
    const bf16_t* base; bf16_t* XB; float* Xf; float* ss;
    struct Pre { u32x2 bw; };
    __device__ __forceinline__ void prefetch4(int row, int col, Pre& p) const { p.bw = *(const u32x2*)(base + (size_t)row * DM + col); }
    __device__ __forceinline__ void apply4(int row, int col, f32x4 v, const Pre& p) const {
        const size_t off = (size_t)row * DM + col; const u32x2 bw = p.bw;
        v = v + (f32x4){bflo(bw.x), bfhi(bw.x), bflo(bw.y), bfhi(bw.y)};
        if (Xf) *(f32x4*)(Xf + off) = v;
        if (XB) { u32x2 w; w.x = pk2(v[0], v[1]); w.y = pk2(v[2], v[3]); *(u32x2*)(XB + off) = w; }
        if (ss) { float sq = (v[0] * v[0] + v[1] * v[1]) + (v[2] * v[2] + v[3] * v[3]); sq += __shfl_xor(sq, 1); sq += __shfl_xor(sq, 2); sq += __shfl_xor(sq, 4); if ((threadIdx.x & 7) == 0) atomicAdd(ss + row, sq); }
    }
    __device__ __forceinline__ void operator()(const f32x4 (&acc)[2][2][4][2], const Unit& u, int wr, int wc, int fr, int fq) const {
        const int row0 = u.pm * 256 + wr * 64 + fr, col0 = u.pn * 256 + wc * 32 + 8 * fq;
#pragma unroll
        for (int ai = 0; ai < 2; ++ai) {
            u32x4 braw[4][2];
#pragma unroll
            for (int m = 0; m < 4; ++m)
#pragma unroll
                for (int bj = 0; bj < 2; ++bj) braw[m][bj] = *(const u32x4*)(base + (size_t)(row0 + ai * 128 + m * 16) * DM + col0 + bj * 128);
            __builtin_amdgcn_sched_barrier(0);
#pragma unroll
            for (int m = 0; m < 4; ++m) { const int row = row0 + ai * 128 + m * 16; const size_t off = (size_t)row * DM + col0; float sq = 0.f;
#pragma unroll
                for (int bj = 0; bj < 2; ++bj) { float b[8]; unpack8(braw[m][bj], b);
                    const f32x4 a0 = acc[ai][bj][m][0], a1 = acc[ai][bj][m][1];
                    const f32x4 v0 = (f32x4){b[0] + a0[0], b[1] + a0[1], b[2] + a0[2], b[3] + a0[3]}, v1 = (f32x4){b[4] + a1[0], b[5] + a1[1], b[6] + a1[2], b[7] + a1[3]};
                    sq += (v0[0] * v0[0] + v0[1] * v0[1]) + (v0[2] * v0[2] + v0[3] * v0[3]) + (v1[0] * v1[0] + v1[1] * v1[1]) + (v1[2] * v1[2] + v1[3] * v1[3]);
                    if (Xf) { *(f32x4*)(Xf + off + bj * 128) = v0; *(f32x4*)(Xf + off + bj * 128 + 4) = v1; }
                    if (XB) { u32x4 w; w.x = pk2(v0[0], v0[1]); w.y = pk2(v0[2], v0[3]); w.z = pk2(v1[0], v1[1]); w.w = pk2(v1[2], v1[3]); *(u32x4*)(XB + off + bj * 128) = w; } }
                if (ss) { sq += __shfl_xor(sq, 16); sq += __shfl_xor(sq, 32); if (fq == 0) atomicAdd(ss + row, sq); } } }
    }
};
struct EpiUp {
    static constexpr bool PERM = true, AFTER_DRAIN = false;
    bf16_t* H; const float* ss;
    struct Pre { float ssv; };
    __device__ __forceinline__ void prefetch4(int row, int col, Pre& p) const { p.ssv = ss[row]; }
    __device__ __forceinline__ void apply4(int row, int col, f32x4 v, const Pre& p) const {
        const float rs = rsqrtf(p.ssv * (1.f / DM) + EPS);
#pragma unroll
        for (int k = 0; k < 4; ++k) { const float t = fmaxf(v[k] * rs, 0.f); v[k] = t * t; }
        u32x2 w; w.x = pk2(v[0], v[1]); w.y = pk2(v[2], v[3]); *(u32x2*)(H + (size_t)row * FF + col) = w;
    }
    __device__ __forceinline__ void operator()(const f32x4 (&acc)[2][2][4][2], const Unit& u, int wr, int wc, int fr, int fq) const {
        const int row0 = u.pm * 256 + wr * 64 + fr, col0 = u.pn * 256 + wc * 32 + 8 * fq;
        float rsv[2][4];
#pragma unroll
        for (int ai = 0; ai < 2; ++ai)
#pragma unroll
            for (int m = 0; m < 4; ++m) rsv[ai][m] = ss[row0 + ai * 128 + m * 16];
        __builtin_amdgcn_sched_barrier(0);
#pragma unroll
        for (int ai = 0; ai < 2; ++ai)
#pragma unroll
            for (int m = 0; m < 4; ++m) { const int row = row0 + ai * 128 + m * 16; const float rs = rsqrtf(rsv[ai][m] * (1.f / DM) + EPS); bf16_t* rowp = H + (size_t)row * FF + col0;
#pragma unroll
                for (int bj = 0; bj < 2; ++bj) { f32x4 v0 = acc[ai][bj][m][0] * rs, v1 = acc[ai][bj][m][1] * rs;
#pragma unroll
                    for (int k = 0; k < 4; ++k) { const float a = fmaxf(v0[k], 0.f), b = fmaxf(v1[k], 0.f); v0[k] = a * a; v1[k] = b * b; }
                    u32x4 w; w.x = pk2(v0[0], v0[1]); w.y = pk2(v0[2], v0[3]); w.z = pk2(v1[0], v1[1]); w.w = pk2(v1[2], v1[3]);
                    *(u32x4*)(rowp + bj * 128) = w; } }
    }
};

template <int CT, class Epi> __device__ __forceinline__ void skinny_gemm(LAS unsigned char* lds, const bf16_t* A, const bf16_t* Bt, int N, int K, const Epi& E, int first) {
    const int tid = opq(threadIdx.x), lane = tid & 63, wave = __builtin_amdgcn_readfirstlane(tid >> 6), r = lane & 15, qd = lane >> 4;
    const int G = gridDim.x, nunits = 8 * (N / (16 * CT)), kw = K / 8, nsteps = kw / 32;
    LAS float* red = (LAS float*)lds;
    for (int u = (int)((blockIdx.x + G - first % G) % G); u < nunits; u += G) {
        const int mt = u & 7, nt = u >> 3;
        const bf16_t* ap = A + (size_t)(NTOK_P + mt * 64 + r) * K + wave * kw + 8 * qd;
        const bf16_t* bp = Bt + (size_t)(nt * 16 * CT + r) * K + wave * kw + 8 * qd;
        typename Epi::Pre pre[CT / 2];
#pragma unroll
        for (int e = 0; e < CT / 2; ++e) { const int idx = tid + e * 512; E.prefetch4(NTOK_P + mt * 64 + idx / (4 * CT), nt * 16 * CT + (idx % (4 * CT)) * 4, pre[e]); }
        f32x4 acc[4][CT];
#pragma unroll
        for (int rt = 0; rt < 4; ++rt)
#pragma unroll
            for (int ct = 0; ct < CT; ++ct) acc[rt][ct] = (f32x4){0.f, 0.f, 0.f, 0.f};
#define SKINNY_GROUP(GS, S0) do { bf16x8 af_[GS][4], bf_[GS][CT]; \
            _Pragma("unroll") for (int q_ = 0; q_ < GS; ++q_) { \
                _Pragma("unroll") for (int rt = 0; rt < 4; ++rt) af_[q_][rt] = *(const bf16x8*)(ap + (size_t)rt * 16 * K + ((S0) + q_) * 32); \
                _Pragma("unroll") for (int ct = 0; ct < CT; ++ct) bf_[q_][ct] = *(const bf16x8*)(bp + (size_t)ct * 16 * K + ((S0) + q_) * 32); } \
            __builtin_amdgcn_sched_barrier(0); \
            _Pragma("unroll") for (int q_ = 0; q_ < GS; ++q_) \
                _Pragma("unroll") for (int rt = 0; rt < 4; ++rt) \
                    _Pragma("unroll") for (int ct = 0; ct < CT; ++ct) acc[rt][ct] = __builtin_amdgcn_mfma_f32_16x16x32_bf16(bf_[q_][ct], af_[q_][rt], acc[rt][ct], 0, 0, 0); \
            __builtin_amdgcn_sched_barrier(0); } while (0)
        if (nsteps >= 4) {
#pragma unroll 1
            for (int s0 = 0; s0 < nsteps; s0 += 4) SKINNY_GROUP(4, s0);
        } else SKINNY_GROUP(2, 0);
#undef SKINNY_GROUP
#pragma unroll
        for (int rt = 0; rt < 4; ++rt)
#pragma unroll
            for (int ct = 0; ct < CT; ++ct) *(LAS f32x4*)(red + wave * (64 * 16 * CT) + (rt * 16 + r) * (16 * CT) + ct * 16 + 4 * qd) = acc[rt][ct];
        __syncthreads();
#pragma unroll
        for (int e = 0; e < CT / 2; ++e) { const int idx = tid + e * 512, row = idx / (4 * CT), c4 = idx % (4 * CT);
            f32x4 v = *(const LAS f32x4*)(red + row * (16 * CT) + c4 * 4);
#pragma unroll
            for (int w = 1; w < 8; ++w) v = v + *(const LAS f32x4*)(red + w * (64 * 16 * CT) + row * (16 * CT) + c4 * 4);
            E.apply4(NTOK_P + mt * 64 + row, nt * 16 * CT + c4 * 4, v, pre[e]); }
        __syncthreads();
    }
}

struct Args { const float* in[28]; float* out; unsigned char* ws; };
enum { I_XP = 0, I_XS, I_CK, I_CV, I_SR, I_SI, I_N1G, I_WIN, I_BG, I_QG, I_KG, I_SINK, I_LRE, I_LIM, I_LSTEP, I_BRE, I_BIM, I_CRE, I_CIM, I_DSK, I_WGLU, I_BGLU, I_WAO, I_WSO, I_WOUT, I_N2G, I_WUP, I_WDN };

struct TItem { const float* W; const float* gain; bf16_t* WT; int K, N, k0, n0; };
__device__ __forceinline__ TItem titem(const Args& a, int it) {
    constexpr int I0 = (DM / 64) * (INC / 256), I1 = (512 / 64) * (512 / 256), I2 = (512 / 64) * (1024 / 256), I3 = I2, I4 = (DM / 64) * (DM / 256), I5 = (DM / 64) * (FF / 256), I6 = (FF / 64) * (DM / 256);
    constexpr int IL = I0 + I1 + I2 + I3 + I4 + I5 + I6;
    const int l = it / IL; int r = it % IL; bf16_t* Wl = (bf16_t*)(a.ws + WS_W) + (size_t)l * W_LAYER; TItem t;
    if (r < I0) { t.W = a.in[I_WIN] + (size_t)l * DM * INC; t.gain = a.in[I_N1G] + l * DM; t.WT = Wl + W_IN; t.K = DM; t.N = INC; }
    else if ((r -= I0) < I1) { t.W = a.in[I_WGLU] + (size_t)l * 512 * 512; t.gain = nullptr; t.WT = Wl + W_GLU; t.K = 512; t.N = 512; }
    else if ((r -= I1) < I2) { t.W = a.in[I_WAO] + (size_t)l * 512 * 1024; t.gain = nullptr; t.WT = Wl + W_AO; t.K = 512; t.N = 1024; }
    else if ((r -= I2) < I3) { t.W = a.in[I_WSO] + (size_t)l * 512 * 1024; t.gain = nullptr; t.WT = Wl + W_SO; t.K = 512; t.N = 1024; }
    else if ((r -= I3) < I4) { t.W = a.in[I_WOUT] + (size_t)l * DM * DM; t.gain = nullptr; t.WT = Wl + W_OUT; t.K = DM; t.N = DM; }
    else if ((r -= I4) < I5) { t.W = a.in[I_WUP] + (size_t)l * DM * FF; t.gain = a.in[I_N2G] + l * DM; t.WT = Wl + W_UP; t.K = DM; t.N = FF; }
    else { r -= I5; t.W = a.in[I_WDN] + (size_t)l * FF * DM; t.gain = nullptr; t.WT = Wl + W_DN; t.K = FF; t.N = DM; }
    const int nblk = t.N / 256; t.k0 = 64 * (r / nblk); t.n0 = 256 * (r % nblk);
    return t;
}
constexpr int T_ITEMS = 2 * ((DM / 64) * (INC / 256) + (512 / 64) * (512 / 256) + 2 * (512 / 64) * (1024 / 256) + (DM / 64) * (DM / 256) + (DM / 64) * (FF / 256) + (FF / 64) * (DM / 256));
__device__ __forceinline__ void prologue(const Args& a, LAS unsigned char* lds, int tid, int wave, int lane) {
    unsigned char* ws = a.ws;
    const int gw = blockIdx.x * 8 + wave, NGW = gridDim.x * 8;
    {   constexpr int TS = 257; LAS float* tile = (LAS float*)lds;
        f32x4 v[8]; int it = blockIdx.x;
        if (it < T_ITEMS) { const TItem t = titem(a, it);
#pragma unroll
            for (int i = 0; i < 8; ++i) { v[i] = __builtin_nontemporal_load((const f32x4*)(t.W + (size_t)(t.k0 + 8 * wave + i) * t.N + t.n0 + 4 * lane)); if (t.gain) v[i] = v[i] * t.gain[t.k0 + 8 * wave + i]; } }
        for (; it < T_ITEMS; it += gridDim.x) {
            const TItem t = titem(a, it);
#pragma unroll
            for (int i = 0; i < 8; ++i) { LAS float* tp = tile + (8 * wave + i) * TS + 4 * lane; tp[0] = v[i][0]; tp[1] = v[i][1]; tp[2] = v[i][2]; tp[3] = v[i][3]; }
            __syncthreads();
            if (it + (int)gridDim.x < T_ITEMS) { const TItem tn = titem(a, it + gridDim.x);
#pragma unroll
                for (int i = 0; i < 8; ++i) { v[i] = __builtin_nontemporal_load((const f32x4*)(tn.W + (size_t)(tn.k0 + 8 * wave + i) * tn.N + tn.n0 + 4 * lane)); if (tn.gain) v[i] = v[i] * tn.gain[tn.k0 + 8 * wave + i]; } }
#pragma unroll
            for (int j = 0; j < 4; ++j) { const int q = tid + 512 * j, n = q >> 3, c = q & 7; const LAS float* s = tile + (8 * c) * TS + n;
                u32x4 o; o.x = pk2(s[0 * TS], s[1 * TS]); o.y = pk2(s[2 * TS], s[3 * TS]); o.z = pk2(s[4 * TS], s[5 * TS]); o.w = pk2(s[6 * TS], s[7 * TS]);
                *(u32x4*)(t.WT + (size_t)(t.n0 + n) * t.K + t.k0 + 8 * c) = o; }
            __syncthreads();
        }
    }
    float* ss = (float*)(ws + WS_SS); bf16_t* XB = (bf16_t*)(ws + WS_A);
    for (int m = gw; m < MTOK; m += NGW) {
        const float* src = (m < NTOK_P) ? a.in[I_XP] + (size_t)m * DM : a.in[I_XS] + (size_t)(m - NTOK_P) * DM;
        f32x4 v[4]; float s = 0.f;
#pragma unroll
        for (int j = 0; j < 4; ++j) { v[j] = __builtin_nontemporal_load((const f32x4*)src + lane + 64 * j); s += (v[j][0] * v[j][0] + v[j][1] * v[j][1]) + (v[j][2] * v[j][2] + v[j][3] * v[j][3]); }
        s = wave_sum(s);
#pragma unroll
        for (int j = 0; j < 4; ++j) { u32x2 w; w.x = pk2(v[j][0], v[j][1]); w.y = pk2(v[j][2], v[j][3]); *((u32x2*)(XB + (size_t)m * DM) + lane + 64 * j) = w; }
        if (lane == 0) ss[m] = s;
    }
    for (int i = blockIdx.x * 512 + tid; i < 3 * MTOK; i += gridDim.x * 512) ss[MTOK + i] = 0.f;
    for (int i = tid < 16 ? (int)blockIdx.x * 16 + tid : 2 * NG * NP; i < 2 * NG * NP; i += gridDim.x * 16) {
        const int l = i / (NG * NP), g = (i / NP) % NG, p = i % NP;
        const float lre = a.in[I_LRE][i], lim = a.in[I_LIM][i], step = expf(a.in[I_LSTEP][l * NG + g]);
        const float mag = expf(lre * step), ar = mag * cosf(lim * step), ai = mag * sinf(lim * step), den = lre * lre + lim * lim;
        const float cr = ((ar - 1.f) * lre + ai * lim) / den, ci = (ai * lre - (ar - 1.f) * lim) / den;
        float pr = ar, pi = ai;
#pragma unroll
        for (int k = 0; k < 8; ++k) { const float nr = pr * pr - pi * pi, ni = 2.f * pr * pi; pr = nr; pi = ni; }
        ((f32x4*)(ws + WS_TA))[i] = (f32x4){ar, ai, pr, pi};
        bf16_t* tbh = (bf16_t*)(ws + WS_TB) + (size_t)(l * NG + g) * 128 * GC;
        const float* bre = a.in[I_BRE] + (size_t)i * GC; const float* bim = a.in[I_BIM] + (size_t)i * GC;
#pragma unroll
        for (int c = 0; c < GC; c += 2) { const float br0 = bre[c], bi0 = bim[c], br1 = bre[c + 1], bi1 = bim[c + 1];
            *(unsigned*)(tbh + (2 * p) * GC + c) = pk2(cr * br0 - ci * bi0, cr * br1 - ci * bi1); *(unsigned*)(tbh + (2 * p + 1) * GC + c) = pk2(cr * bi0 + ci * br0, cr * bi1 + ci * br1); }
        bf16_t* tc = (bf16_t*)(ws + WS_TC) + (size_t)(l * NG + g) * GC * 128;
        const float* cre = a.in[I_CRE] + (size_t)(l * NG + g) * GC * NP; const float* cim = a.in[I_CIM] + (size_t)(l * NG + g) * GC * NP;
#pragma unroll
        for (int c = 0; c < GC; ++c) *(unsigned*)(tc + c * 128 + 2 * p) = pk2(cre[c * NP + p], -cim[c * NP + p]);
    }
}

__device__ __forceinline__ void attn_prompt_unit(const Args& a, LAS unsigned char* lds, int l, int b, int qb, int kvh, int tid) {
    constexpr int KST = 72, VST = 272;
    LAS bf16_t* Ks = (LAS bf16_t*)lds; LAS bf16_t* Vt = Ks + 256 * KST; LAS float* kmaxs = (LAS float*)(Vt + 64 * VST);
    const bf16_t* Z = (const bf16_t*)(a.ws + WS_C);
    const float* gk = a.in[I_KG] + l * 64; const float* gq = a.in[I_QG] + l * 64;
    const int wave = tid >> 6, lane = tid & 63, r = lane & 15, qd = lane >> 4, g = wave >> 1, qh = wave & 1, h = kvh * 4 + g;
    const size_t qrow0 = (size_t)b * SEQ + qb * WIN + qh * 64;
    u32x4 qraw[4][2];
#pragma unroll
    for (int qt = 0; qt < 4; ++qt) { const bf16_t* zq = Z + (qrow0 + qt * 16 + r) * INC + ZQ + h * 64 + 8 * qd; qraw[qt][0] = *(const u32x4*)zq; qraw[qt][1] = *(const u32x4*)(zq + 32); }
    f32x4 gkv[8], gqv[4];
#pragma unroll
    for (int c = 0; c < 8; ++c) gkv[c] = *(const f32x4*)(gk + (tid & 1) * 32 + 4 * c);
#pragma unroll
    for (int c = 0; c < 4; ++c) gqv[c] = *(const f32x4*)(gq + (c >> 1) * 32 + 8 * qd + 4 * (c & 1));
    {
        const int j = tid >> 1, half = tid & 1, pos = (qb - 1) * WIN + j; const bool valid = pos >= 0;
        float kf[32]; u32x4 vraw[4];
        if (valid) { const bf16_t* zr = Z + (size_t)(b * SEQ + pos) * INC + kvh * 64 + half * 32;
#pragma unroll
            for (int c = 0; c < 4; ++c) { float t8[8]; unpack8(*(const u32x4*)(zr + ZK + c * 8), t8);
#pragma unroll
                for (int k = 0; k < 8; ++k) kf[c * 8 + k] = t8[k];
                vraw[c] = *(const u32x4*)(zr + ZV + c * 8); }
        } else {
#pragma unroll
            for (int k = 0; k < 32; ++k) kf[k] = 0.f;
#pragma unroll
            for (int c = 0; c < 4; ++c) vraw[c] = (u32x4){0u, 0u, 0u, 0u}; }
        float sq = 0.f;
#pragma unroll
        for (int k = 0; k < 32; ++k) sq += kf[k] * kf[k];
        sq += __shfl_xor(sq, 1);
        const float rs = rsqrtf(sq * (1.f / 64.f) + EPS); float n2 = 0.f;
#pragma unroll
        for (int k = 0; k < 32; ++k) { kf[k] = kf[k] * rs * gkv[k >> 2][k & 3]; n2 += kf[k] * kf[k]; }
        n2 += __shfl_xor(n2, 1);
        { float wm = n2;
#pragma unroll
          for (int o = 1; o < 64; o <<= 1) wm = fmaxf(wm, __shfl_xor(wm, o));
          if (lane == 0) kmaxs[wave] = sqrtf(wm); }
#pragma unroll
        for (int c = 0; c < 4; ++c) { u32x4 w; w.x = pk2(kf[8 * c], kf[8 * c + 1]); w.y = pk2(kf[8 * c + 2], kf[8 * c + 3]); w.z = pk2(kf[8 * c + 4], kf[8 * c + 5]); w.w = pk2(kf[8 * c + 6], kf[8 * c + 7]);
            *(LAS u32x4*)(Ks + j * KST + half * 32 + c * 8) = w; }
#pragma unroll
        for (int c = 0; c < 4; ++c) { const unsigned w4[4] = {vraw[c].x, vraw[c].y, vraw[c].z, vraw[c].w};
#pragma unroll
            for (int k = 0; k < 4; ++k) { Vt[(half * 32 + c * 8 + 2 * k) * VST + j] = (bf16_t)(w4[k] & 0xffffu); Vt[(half * 32 + c * 8 + 2 * k + 1) * VST + j] = (bf16_t)(w4[k] >> 16); } }
        if (qb == SEQ / WIN - 1 && j >= WIN) {
            float* ko = a.out + O_KP + ((((size_t)l * NBATCH + b) * WIN + (j - WIN)) * 2 + kvh) * 64 + half * 32;
            float* vo = a.out + O_VP + ((((size_t)l * NBATCH + b) * WIN + (j - WIN)) * 2 + kvh) * 64 + half * 32;
#pragma unroll
            for (int c = 0; c < 8; ++c) *(f32x4*)(ko + 4 * c) = (f32x4){kf[4 * c], kf[4 * c + 1], kf[4 * c + 2], kf[4 * c + 3]};
#pragma unroll
            for (int c = 0; c < 4; ++c) { *(f32x4*)(vo + 8 * c) = (f32x4){bflo(vraw[c].x), bfhi(vraw[c].x), bflo(vraw[c].y), bfhi(vraw[c].y)}; *(f32x4*)(vo + 8 * c + 4) = (f32x4){bflo(vraw[c].z), bfhi(vraw[c].z), bflo(vraw[c].w), bfhi(vraw[c].w)}; }
        }
    }
    __syncthreads();
    float kmax = kmaxs[0];
#pragma unroll
    for (int w = 1; w < 8; ++w) kmax = fmaxf(kmax, kmaxs[w]);
    const float cs = 0.125f * LOG2E, sinkl = a.in[I_SINK][l * 8 + h] * LOG2E, slope = exp2f(-(float)(h + 1)) * LOG2E;
    bf16x8 qf[4][2]; float mref[4];
#pragma unroll
    for (int qt = 0; qt < 4; ++qt) {
        float x[16]; { float t8[8]; unpack8(qraw[qt][0], t8);
#pragma unroll
            for (int k = 0; k < 8; ++k) x[k] = t8[k];
            unpack8(qraw[qt][1], t8);
#pragma unroll
            for (int k = 0; k < 8; ++k) x[8 + k] = t8[k]; }
        float sq = 0.f;
#pragma unroll
        for (int k = 0; k < 16; ++k) sq += x[k] * x[k];
        sq += __shfl_xor(sq, 16); sq += __shfl_xor(sq, 32);
        const float rs = rsqrtf(sq * (1.f / 64.f) + EPS); float n2 = 0.f;
#pragma unroll
        for (int k = 0; k < 16; ++k) { x[k] = x[k] * rs * gqv[k >> 2][k & 3]; n2 += x[k] * x[k]; }
        n2 += __shfl_xor(n2, 16); n2 += __shfl_xor(n2, 32);
        mref[qt] = fmaxf(sinkl, sqrtf(n2) * kmax * cs);
#pragma unroll
        for (int s = 0; s < 2; ++s) { u32x4 w; w.x = pk2(x[8 * s] * cs, x[8 * s + 1] * cs); w.y = pk2(x[8 * s + 2] * cs, x[8 * s + 3] * cs); w.z = pk2(x[8 * s + 4] * cs, x[8 * s + 5] * cs); w.w = pk2(x[8 * s + 6] * cs, x[8 * s + 7] * cs);
            qf[qt][s] = __builtin_bit_cast(bf16x8, w); }
    }
    f32x4 O[4][4]; float lsum[4];
#pragma unroll
    for (int qt = 0; qt < 4; ++qt) { lsum[qt] = 0.f;
#pragma unroll
        for (int dt = 0; dt < 4; ++dt) O[qt][dt] = (f32x4){0.f, 0.f, 0.f, 0.f}; }
    const int base = r - 4 * qd;
#pragma unroll
    for (int qt = 0; qt < 4; ++qt) mref[qt] += slope * (float)base;
#pragma unroll 1
    for (int ks = (qb == 0 ? (4 - 2 * qh) : 0); ks < 6; ++ks) {
        const int J = qh * 64 + ks * 32, base2 = base - 32 * ks; const float sk = slope * (float)(32 * ks);
        bf16x8 kfr[2][2], vfr[4];
#pragma unroll
        for (int T = 0; T < 2; ++T)
#pragma unroll
            for (int s = 0; s < 2; ++s) kfr[T][s] = *(const LAS bf16x8*)(Ks + (J + 16 * T + r) * KST + 32 * s + 8 * qd);
#pragma unroll
        for (int dt = 0; dt < 4; ++dt) { const u32x2 lo = *(const LAS u32x2*)(Vt + (dt * 16 + r) * VST + J + 4 * qd), hi = *(const LAS u32x2*)(Vt + (dt * 16 + r) * VST + J + 16 + 4 * qd);
            vfr[dt] = __builtin_bit_cast(bf16x8, (u32x4){lo.x, lo.y, hi.x, hi.y}); }
#pragma unroll
        for (int qt = 0; qt < 4; ++qt) {
            if (ks * 32 + 31 >= qt * 16 && ks * 32 <= qt * 16 + 143) {
                f32x4 S[2];
#pragma unroll
                for (int T = 0; T < 2; ++T) { S[T] = __builtin_amdgcn_mfma_f32_16x16x32_bf16(kfr[T][0], qf[qt][0], (f32x4){0.f, 0.f, 0.f, 0.f}, 0, 0, 0); S[T] = __builtin_amdgcn_mfma_f32_16x16x32_bf16(kfr[T][1], qf[qt][1], S[T], 0, 0, 0); }
                const float mt = mref[qt] - sk; float p[2][4];
#pragma unroll
                for (int T = 0; T < 2; ++T)
#pragma unroll
                    for (int i = 0; i < 4; ++i) { const int cst = WIN + 16 * qt - 16 * T - i; const unsigned dist = (unsigned)(cst + base2);
                        const float e = __builtin_amdgcn_exp2f((S[T][i] - mt) - slope * (float)cst); p[T][i] = dist <= (unsigned)WIN ? e : 0.f; lsum[qt] += p[T][i]; }
                u32x4 w; w.x = pk2(p[0][0], p[0][1]); w.y = pk2(p[0][2], p[0][3]); w.z = pk2(p[1][0], p[1][1]); w.w = pk2(p[1][2], p[1][3]);
                const bf16x8 pf = __builtin_bit_cast(bf16x8, w);
#pragma unroll
                for (int dt = 0; dt < 4; ++dt) O[qt][dt] = __builtin_amdgcn_mfma_f32_16x16x32_bf16(vfr[dt], pf, O[qt][dt], 0, 0, 0);
            }
        }
    }
#pragma unroll
    for (int qt = 0; qt < 4; ++qt) mref[qt] -= slope * (float)base;
#pragma unroll
    for (int qt = 0; qt < 4; ++qt) {
        float ls = lsum[qt]; ls += __shfl_xor(ls, 16); ls += __shfl_xor(ls, 32);
        const float inv = 1.f / (ls + __builtin_amdgcn_exp2f(sinkl - mref[qt]));
        bf16_t* op = (bf16_t*)(a.ws + WS_B) + (qrow0 + qt * 16 + r) * 512 + h * 64 + 4 * qd;
#pragma unroll
        for (int dt = 0; dt < 4; ++dt) { u32x2 w; w.x = pk2(O[qt][dt][0] * inv, O[qt][dt][1] * inv); w.y = pk2(O[qt][dt][2] * inv, O[qt][dt][3] * inv); *(u32x2*)(op + dt * 16) = w; }
    }
    __syncthreads();
}
__device__ __forceinline__ void attn_sample_unit(const Args& a, LAS unsigned char* lds, int l, int b, int kvh, int tid) {
    constexpr int KST = 72, VST = 176, NKP = 160;
    LAS bf16_t* Ks = (LAS bf16_t*)lds; LAS bf16_t* Vt = Ks + NKP * KST;
    const bf16_t* Z = (const bf16_t*)(a.ws + WS_C);
    const float* gk = a.in[I_KG] + l * 64; const float* gq = a.in[I_QG] + l * 64;
    const float* ck = a.in[I_CK] + ((size_t)l * DEC_B + b) * WIN * 128 + kvh * 64; const float* cv = a.in[I_CV] + ((size_t)l * DEC_B + b) * WIN * 128 + kvh * 64;
    float* ko = a.out + O_KS + ((size_t)l * DEC_B + b) * WIN * 128 + kvh * 64; float* vo = a.out + O_VS + ((size_t)l * DEC_B + b) * WIN * 128 + kvh * 64;
    const size_t zrow0 = (size_t)NTOK_P + b * DEC_T;
    const int lane = tid & 63, r = lane & 15, qd = lane >> 4, t = r >> 2, h = kvh * 4 + (r & 3);
    u32x4 qraw[2];
    { const bf16_t* zq = Z + (zrow0 + t) * INC + ZQ + h * 64 + 8 * qd; qraw[0] = *(const u32x4*)zq; qraw[1] = *(const u32x4*)(zq + 32); }
    {
        f32x4 kv[4], vv[4];
#pragma unroll
        for (int k = 0; k < 4; ++k) { const int idx = tid + 512 * k, row = idx >> 4, c4 = idx & 15; kv[k] = *(const f32x4*)(ck + (size_t)row * 128 + c4 * 4); vv[k] = *(const f32x4*)(cv + (size_t)row * 128 + c4 * 4); }
        for (int i = tid; i < (NKP - WIN - DEC_T) * 64; i += 512) { const int row = WIN + DEC_T + (i >> 6), d = i & 63; Ks[row * KST + d] = 0; Vt[d * VST + row] = 0; }
#pragma unroll
        for (int k = 0; k < 4; ++k) { const int idx = tid + 512 * k, row = idx >> 4, c4 = idx & 15;
            u32x2 w; w.x = pk2(kv[k][0], kv[k][1]); w.y = pk2(kv[k][2], kv[k][3]); *(LAS u32x2*)(Ks + row * KST + c4 * 4) = w;
#pragma unroll
            for (int i = 0; i < 4; ++i) Vt[(c4 * 4 + i) * VST + row] = f2bf(vv[k][i]);
            if (row >= DEC_T) { *(f32x4*)(ko + (size_t)(row - DEC_T) * 128 + c4 * 4) = kv[k]; *(f32x4*)(vo + (size_t)(row - DEC_T) * 128 + c4 * 4) = vv[k]; } }
        if (tid < 256) { const int t2 = tid >> 6, d = tid & 63; const bf16_t* zr = Z + (zrow0 + t2) * INC + kvh * 64 + d;
            const float kr = bf2f(zr[ZK]), vr = bf2f(zr[ZV]); const float sq = wave_sum(kr * kr); const float kn = kr * rsqrtf(sq * (1.f / 64.f) + EPS) * gk[d];
            Ks[(WIN + t2) * KST + d] = f2bf(kn); Vt[d * VST + WIN + t2] = zr[ZV]; ko[(size_t)(WIN - DEC_T + t2) * 128 + d] = kn; vo[(size_t)(WIN - DEC_T + t2) * 128 + d] = vr; }
    }
    __syncthreads();
    if (tid < 64) {
        const float cs = 0.125f * LOG2E, sinkl = a.in[I_SINK][l * 8 + h] * LOG2E, slope = exp2f(-(float)(h + 1)) * LOG2E;
        bf16x8 qf[2];
        {   float x[16]; { float t8[8]; unpack8(qraw[0], t8);
#pragma unroll
                for (int k = 0; k < 8; ++k) x[k] = t8[k];
                unpack8(qraw[1], t8);
#pragma unroll
                for (int k = 0; k < 8; ++k) x[8 + k] = t8[k]; }
            float sq = 0.f;
#pragma unroll
            for (int k = 0; k < 16; ++k) sq += x[k] * x[k];
            sq += __shfl_xor(sq, 16); sq += __shfl_xor(sq, 32);
            const float rs = rsqrtf(sq * (1.f / 64.f) + EPS) * cs;
#pragma unroll
            for (int k = 0; k < 16; ++k) x[k] = x[k] * rs * gq[(k >> 3) * 32 + 8 * qd + (k & 7)];
#pragma unroll
            for (int s = 0; s < 2; ++s) { u32x4 w; w.x = pk2(x[8 * s], x[8 * s + 1]); w.y = pk2(x[8 * s + 2], x[8 * s + 3]); w.z = pk2(x[8 * s + 4], x[8 * s + 5]); w.w = pk2(x[8 * s + 6], x[8 * s + 7]);
                qf[s] = __builtin_bit_cast(bf16x8, w); } }
        f32x4 S[NKP / 16]; float mx = -1e30f;
#pragma unroll
        for (int T = 0; T < NKP / 16; ++T) {
            const bf16x8 k0 = *(const LAS bf16x8*)(Ks + (16 * T + r) * KST + 8 * qd), k1 = *(const LAS bf16x8*)(Ks + (16 * T + r) * KST + 32 + 8 * qd);
            S[T] = __builtin_amdgcn_mfma_f32_16x16x32_bf16(k0, qf[0], (f32x4){0.f, 0.f, 0.f, 0.f}, 0, 0, 0); S[T] = __builtin_amdgcn_mfma_f32_16x16x32_bf16(k1, qf[1], S[T], 0, 0, 0); }
#pragma unroll
        for (int T = 0; T < NKP / 16; ++T)
#pragma unroll
            for (int i = 0; i < 4; ++i) { const int dist = WIN + t - (16 * T + 4 * qd + i);
                const float s = (unsigned)dist <= (unsigned)WIN ? S[T][i] - slope * (float)dist : -1e30f; S[T][i] = s; mx = fmaxf(mx, s); }
        mx = fmaxf(mx, __shfl_xor(mx, 16)); mx = fmaxf(mx, __shfl_xor(mx, 32)); mx = fmaxf(mx, sinkl);
        float lsum = 0.f;
#pragma unroll
        for (int T = 0; T < NKP / 16; ++T)
#pragma unroll
            for (int i = 0; i < 4; ++i) { const float p = S[T][i] > -1e29f ? __builtin_amdgcn_exp2f(S[T][i] - mx) : 0.f; S[T][i] = p; lsum += p; }
        f32x4 O[4];
#pragma unroll
        for (int dt = 0; dt < 4; ++dt) O[dt] = (f32x4){0.f, 0.f, 0.f, 0.f};
#pragma unroll
        for (int st = 0; st < NKP / 32; ++st) {
            u32x4 w; w.x = pk2(S[2 * st][0], S[2 * st][1]); w.y = pk2(S[2 * st][2], S[2 * st][3]); w.z = pk2(S[2 * st + 1][0], S[2 * st + 1][1]); w.w = pk2(S[2 * st + 1][2], S[2 * st + 1][3]);
            const bf16x8 pf = __builtin_bit_cast(bf16x8, w);
#pragma unroll
            for (int dt = 0; dt < 4; ++dt) { const u32x2 lo = *(const LAS u32x2*)(Vt + (dt * 16 + r) * VST + 32 * st + 4 * qd), hi = *(const LAS u32x2*)(Vt + (dt * 16 + r) * VST + 32 * st + 16 + 4 * qd);
                O[dt] = __builtin_amdgcn_mfma_f32_16x16x32_bf16(__builtin_bit_cast(bf16x8, (u32x4){lo.x, lo.y, hi.x, hi.y}), pf, O[dt], 0, 0, 0); }
        }
        lsum += __shfl_xor(lsum, 16); lsum += __shfl_xor(lsum, 32);
        const float inv = __builtin_amdgcn_rcpf(lsum + __builtin_amdgcn_exp2f(sinkl - mx));
        bf16_t* op = (bf16_t*)(a.ws + WS_B) + (zrow0 + t) * 512 + h * 64 + 4 * qd;
#pragma unroll
        for (int dt = 0; dt < 4; ++dt) { u32x2 w; w.x = pk2(O[dt][0] * inv, O[dt][1] * inv); w.y = pk2(O[dt][2] * inv, O[dt][3] * inv); *(u32x2*)(op + dt * 16) = w; }
    }
    __syncthreads();
}

struct SsmTab { f32x4 ta; bf16x8 af[8]; bf16x8 cf[4]; float dsk; };
template <bool PASS_B> __device__ __forceinline__ void ssm_tables(const Args& a, int l, int gq, int wave, SsmTab& T) {
    const int lane = opq(threadIdx.x) & 63, r = lane & 15, qd = lane >> 4, g = gq * 8 + wave;
    T.ta = ((const f32x4*)(a.ws + WS_TA))[(l * NG + g) * NP + lane];
    const bf16_t* tbh = (const bf16_t*)(a.ws + WS_TB) + (size_t)(l * NG + g) * 128 * GC + r * GC + 8 * (qd & 1);
#pragma unroll
    for (int pt = 0; pt < 8; ++pt) { const bf16x8 v = *(const bf16x8*)(tbh + pt * 16 * GC); T.af[pt] = qd < 2 ? v : (bf16x8){0, 0, 0, 0, 0, 0, 0, 0}; }
    T.dsk = 0.f;
    if (PASS_B) { const bf16_t* tc = (const bf16_t*)(a.ws + WS_TC) + (size_t)(l * NG + g) * GC * 128 + r * 128 + qd * 8;
#pragma unroll
        for (int s = 0; s < 4; ++s) T.cf[s] = *(const bf16x8*)(tc + s * 32);
        T.dsk = a.in[I_DSK][l * 512 + g * 16 + r]; }
}
__device__ __forceinline__ void ssm_stage_load(const Args& a, size_t row0, int ntok, int gq, u32x4 (&pre)[2]) {
    const int tid = opq(threadIdx.x); const bf16_t* Z = (const bf16_t*)(a.ws + WS_C);
#pragma unroll
    for (int k = 0; k < 2; ++k) { const int idx = tid + 512 * k, t = idx >> 4, c8 = idx & 15; if (idx < ntok * 16) pre[k] = *(const u32x4*)(Z + (row0 + t) * INC + ZU + gq * 128 + c8 * 8); }
}
template <bool PASS_B> __device__ __forceinline__ void ssm_unit(const Args& a, LAS unsigned char* lds, const SsmTab& T, const u32x4 (&pre)[2], int l, size_t row0, int ntok, int gq, float& hr_io, float& hi_io, int wave) {
    const int tid = opq(threadIdx.x), lane = tid & 63, r = lane & 15, qd = lane >> 4;
    constexpr int UST = 136, XST = 132, HST = 136;
    LAS bf16_t* Ub = (LAS bf16_t*)lds;
    LAS float* Xs = (LAS float*)(lds + 64 * UST * 2) + wave * (16 * XST);
    LAS bf16_t* hb = (LAS bf16_t*)(lds + 64 * UST * 2 + 8 * 16 * XST * 4) + wave * (16 * HST);
    const int g = gq * 8 + wave;
    const f32x4 ta = T.ta; const float ar = ta[0], ai = ta[1], dsk = T.dsk;
    float hr = hr_io, hi = hi_io;
#pragma unroll
    for (int k = 0; k < 2; ++k) { const int idx = tid + 512 * k, t = idx >> 4, c8 = idx & 15; if (idx < ntok * 16) *(LAS u32x4*)(Ub + t * UST + c8 * 8) = pre[k]; }
    __syncthreads();
#pragma unroll 1
    for (int t0 = 0; t0 < ntok; t0 += 16) {
        const int nt = (ntok - t0) < 16 ? (ntok - t0) : 16;
        {
            const bf16x8 uv = *(const LAS bf16x8*)(Ub + (t0 + r) * UST + wave * 16 + 8 * (qd & 1)); const bf16x8 ub = qd < 2 ? uv : (bf16x8){0, 0, 0, 0, 0, 0, 0, 0};
#pragma unroll
            for (int pt = 0; pt < 8; ++pt) { const f32x4 x = __builtin_amdgcn_mfma_f32_16x16x32_bf16(T.af[pt], ub, (f32x4){0.f, 0.f, 0.f, 0.f}, 0, 0, 0); *(LAS f32x4*)(Xs + r * XST + pt * 16 + 4 * qd) = x; }
        }
        asm volatile("s_waitcnt lgkmcnt(0)" ::: "memory");
        {
            typedef float f32x2 __attribute__((ext_vector_type(2)));
            f32x2 xv[16];
#pragma unroll
            for (int tt = 0; tt < 16; ++tt) xv[tt] = *(const LAS f32x2*)(Xs + tt * XST + 2 * lane);
            f32x2 h = {hr, hi}; const f32x2 a1 = {ar, ar}, a2 = {-ai, ai};
            if (nt == 16) {
#pragma unroll
                for (int tt = 0; tt < 16; ++tt) { const f32x2 hs = {h.y, h.x}; h = a1 * h + (a2 * hs + xv[tt]);
                    if (PASS_B) *(LAS unsigned*)(hb + tt * HST + 2 * lane) = pk2(h.x, h.y); }
            } else {
#pragma unroll
                for (int tt = 0; tt < 16; ++tt) if (tt < nt) { const f32x2 hs = {h.y, h.x}; h = a1 * h + (a2 * hs + xv[tt]);
                    if (PASS_B) *(LAS unsigned*)(hb + tt * HST + 2 * lane) = pk2(h.x, h.y); }
            }
            hr = h.x; hi = h.y;
        }
        if (PASS_B) {
            f32x4 acc = {0.f, 0.f, 0.f, 0.f};
            asm volatile("s_waitcnt lgkmcnt(0)" ::: "memory");
#pragma unroll
            for (int s = 0; s < 4; ++s) { const bf16x8 hf = *(const LAS bf16x8*)(hb + r * HST + s * 32 + qd * 8); acc = __builtin_amdgcn_mfma_f32_16x16x32_bf16(hf, T.cf[s], acc, 0, 0, 0); }
            asm volatile("s_waitcnt lgkmcnt(0)" ::: "memory");
            bf16_t* yo = (bf16_t*)(a.ws + WS_B + HALFROWS);
#pragma unroll
            for (int k = 0; k < 4; ++k) { const int tt = 4 * qd + k;
                if (tt < nt) { const float y = acc[k] + dsk * bf2f(Ub[(t0 + tt) * UST + wave * 16 + r]); yo[(row0 + t0 + tt) * 512 + g * 16 + r] = f2bf(gelu_tanh(y)); } }
        }
        asm volatile("s_waitcnt lgkmcnt(0)" ::: "memory");
    }
    hr_io = hr; hi_io = hi;
    __syncthreads();
}

#define XB_TMO      128
#define XB_XCNT(j)  (256  + 64 * (j))
#define XB_XSUB(j)  (1280 + 64 * (j))
#define XB_XGEN(j)  (2304 + 64 * (j))
#define XB_TOP      3328
#define XB_TOPGEN   3392
#define XCD_BAR_WORDS 3456
#define XB_SPIN_CAP (1u << 18)

__device__ __forceinline__ unsigned xb_ld(unsigned* p)              { return __hip_atomic_load(p, __ATOMIC_RELAXED, __HIP_MEMORY_SCOPE_AGENT); }
__device__ __forceinline__ unsigned xb_add(unsigned* p, unsigned v) { return __hip_atomic_fetch_add(p, v, __ATOMIC_RELAXED, __HIP_MEMORY_SCOPE_AGENT); }
__device__ __forceinline__ unsigned xb_xcc_id() { return (unsigned)__builtin_amdgcn_s_getreg((3 << 11) | 20) & 0xFu; }
#define XB_SPIN(cond, bar) do { unsigned _sp = 0; while (cond) { __builtin_amdgcn_s_sleep(1); \
    if ((++_sp & 255u) == 0u) { if (xb_ld(&(bar)[XB_TMO])) break; if (_sp > XB_SPIN_CAP) { atomicAdd(&(bar)[XB_TMO], 1u); break; } } } } while (0)

struct XcdBarrier {
    unsigned* bar; unsigned x;
    volatile LAS unsigned* st;
};

__device__ __forceinline__ XcdBarrier xcd_barrier_post(unsigned* bar, volatile LAS unsigned* st) {
    XcdBarrier b; b.bar = bar; b.x = xb_xcc_id(); b.st = st;
    if (threadIdx.x == 0) (void)xb_add(&bar[XB_XCNT(b.x)], 1u);
    return b;
}
__device__ __forceinline__ void xcd_barrier_complete(unsigned* bar, unsigned x, unsigned& nloc, unsigned& nx) {
    const unsigned G = gridDim.x * gridDim.y * gridDim.z;
    unsigned sum, cnt, mine, sp = 0u;
    for (;;) {
        sum = 0u; cnt = 0u; mine = 0u;
#pragma unroll
        for (unsigned j = 0; j < 16; ++j) { const unsigned c = xb_ld(&bar[XB_XCNT(j)]); sum += c; cnt += (c > 0u) ? 1u : 0u; mine = (j == x) ? c : mine; }
        if (sum == G) break;
        __builtin_amdgcn_s_sleep(1);
        if ((++sp & 255u) == 0u) { if (xb_ld(&bar[XB_TMO])) break; if (sp > XB_SPIN_CAP) { atomicAdd(&bar[XB_TMO], 1u); break; } }
    }
    nloc = mine > 0u ? mine : 1u; nx = cnt > 0u ? cnt : 1u;
}

__device__ __forceinline__ void xcd_barrier(const XcdBarrier& b) {
    asm volatile("s_waitcnt vmcnt(0)" ::: "memory");
    __syncthreads();
    if (threadIdx.x == 0) {
        unsigned* bar = b.bar;
        __builtin_amdgcn_s_waitcnt(0);
        unsigned nloc = b.st[0], nx = b.st[1];
        if (nloc == 0u) { xcd_barrier_complete(bar, b.x, nloc, nx); b.st[0] = nloc; b.st[1] = nx; }
        const unsigned old = xb_add(&bar[XB_XSUB(b.x)], 1u);
        const unsigned gen = old / nloc;
        if (old + 1u == (gen + 1u) * nloc) {
            __builtin_amdgcn_fence(__ATOMIC_RELEASE, "agent");
            asm volatile("s_waitcnt vmcnt(0)" ::: "memory");
            const unsigned og = xb_add(&bar[XB_TOP], 1u);
            const unsigned tg = og / nx;
            if (og + 1u == (tg + 1u) * nx) xb_add(&bar[XB_TOPGEN], 1u);
            else XB_SPIN(xb_ld(&bar[XB_TOPGEN]) == tg, bar);
            __builtin_amdgcn_fence(__ATOMIC_ACQUIRE, "agent");
            xb_add(&bar[XB_XGEN(b.x)], 1u);
            asm volatile("s_waitcnt vmcnt(0)" ::: "memory");
        } else {
            XB_SPIN(xb_ld(&bar[XB_XGEN(b.x)]) == gen, bar);
            __builtin_amdgcn_fence(__ATOMIC_ACQUIRE, "agent");
            asm volatile("s_waitcnt vmcnt(0)" ::: "memory");
        }
    }
    __syncthreads();
}

__global__ void __launch_bounds__(512, 2) mk_fwd(Args a) {
    extern __shared__ __attribute__((aligned(16))) unsigned char lds_raw[];
    LAS unsigned char* lds = (LAS unsigned char*)lds_raw;
    cg::grid_group grid = cg::this_grid();
    const int tid = threadIdx.x, lane = tid & 63, wave = __builtin_amdgcn_readfirstlane(tid >> 6);
    const int G = gridDim.x, bx = blockIdx.x;
    unsigned char* ws = a.ws;
    float* ss = (float*)(ws + WS_SS);
    bf16_t* bufA = (bf16_t*)(ws + WS_A);
    bf16_t* mixed = (bf16_t*)a.out;
    bf16_t* attn = (bf16_t*)(ws + WS_B); bf16_t* ssmy = (bf16_t*)(ws + WS_B + HALFROWS); bf16_t* xb2 = (bf16_t*)(ws + WS_B);
    bf16_t* Z = (bf16_t*)(ws + WS_C); bf16_t* ssmg = (bf16_t*)(ws + WS_C + ZBYTES); float* Ebuf = (float*)(ws + WS_C + ZBYTES + HALFROWS); bf16_t* H = (bf16_t*)(ws + WS_C);

    unsigned* barw = (unsigned*)(ws + 16384);
    volatile LAS unsigned* bst = (volatile LAS unsigned*)(lds + LDS_BYTES - 64);
    if (bx == 0) for (int i = tid; i < XCD_BAR_WORDS; i += 512) barw[i] = 0u;
    if (tid < 2) bst[tid] = 0u;
    __syncthreads();
    grid.sync();
    { const int t2 = opq(threadIdx.x); prologue(a, lds, t2, wave, t2 & 63); }
    (void)xcd_barrier_post(barw, bst);
#define GRID_BAR() do { XcdBarrier b_; b_.bar = (unsigned*)(a.ws + 16384); b_.x = xb_xcc_id(); b_.st = (volatile LAS unsigned*)(lds + LDS_BYTES - 64); xcd_barrier(b_); } while (0)
    GRID_BAR();
#pragma unroll 1
    for (int l = 0; l < 2; ++l) {
        const bf16_t* Wl = (const bf16_t*)(ws + WS_W) + (size_t)l * W_LAYER;
        float* ss1 = ss + (size_t)(2 * l) * MTOK; float* ss2 = ss + (size_t)(2 * l + 1) * MTOK; float* ss1n = ss + (size_t)(2 * l + 2) * MTOK;
        { pg8::Gemm g{bufA, Wl + W_IN, NTOK_P, INC - 256, DM}; pg8::StaticOrder S; S.init(NTOK_P, INC - 256, G, bx); EpiIn E{Z, ss1, a.in[I_BG] + l * 2048, 0};
          pg8::gemm_phase<EpiIn, pg8::StaticOrder, true, true>(lds, g, S, E);
          skinny_gemm<4>(lds, bufA, Wl + W_IN, INC, DM, E, 0); }
        GRID_BAR();
#ifndef REP_MIX
#define REP_MIX 1
#endif
#pragma unroll 1
        for (int rep = 0; rep < REP_MIX; ++rep) {
#ifndef SKIP_AP
        for (int u = bx; u < 256; u += G) attn_prompt_unit(a, lds, l, u >> 5, (u >> 1) & 15, u & 1, opq(threadIdx.x));
#endif
#ifndef SKIP_AS
        for (int u = bx; u < 2 * DEC_B; u += G) attn_sample_unit(a, lds, l, u >> 1, u & 1, opq(threadIdx.x));
#endif
#ifndef SKIP_SA
        {   SsmTab T; ssm_tables<false>(a, l, bx & 3, wave, T); u32x4 pre[2];
            for (int u = bx; u < NBATCH * (NSEG - 1) * 4; u += G) { const int gq = u & 3, seg = (u >> 2) % (NSEG - 1), b = (u >> 2) / (NSEG - 1);
                const size_t r0 = (size_t)b * SEQ + (size_t)seg * (SEGB * SBLK); float hr = 0.f, hi = 0.f;
                ssm_stage_load(a, r0, SBLK, gq, pre);
#pragma unroll 1
                for (int blk = 0; blk < SEGB; ++blk) { u32x4 cur[2] = {pre[0], pre[1]};
                    if (blk + 1 < SEGB) ssm_stage_load(a, r0 + (blk + 1) * SBLK, SBLK, gq, pre);
                    ssm_unit<false>(a, lds, T, cur, l, r0 + blk * SBLK, SBLK, gq, hr, hi, wave); }
                const int lane = opq(threadIdx.x) & 63, g = gq * 8 + wave;
                *(float2*)(Ebuf + ((((size_t)b * NSEG + seg) * NG + g) * NP + lane) * 2) = make_float2(hr, hi); } }
#endif
        GRID_BAR();
        {   SsmTab T; ssm_tables<true>(a, l, bx & 3, wave, T); u32x4 pre[2];
            for (int u = bx; u < NBATCH * NSEG * 4; u += G) { const int gq = u & 3, seg = (u >> 2) % NSEG, b = (u >> 2) / NSEG;
                const size_t r0 = (size_t)b * SEQ + (size_t)seg * (SEGB * SBLK); const int lane = opq(threadIdx.x) & 63, g = gq * 8 + wave;
                ssm_stage_load(a, r0, SBLK, gq, pre);
                float hr = 0.f, hi = 0.f;
                {
                    float2 e[NSEG - 1];
#pragma unroll
                    for (int i = 0; i < NSEG - 1; ++i) e[i] = (i < seg) ? *(const float2*)(Ebuf + ((((size_t)b * NSEG + i) * NG + g) * NP + lane) * 2) : make_float2(0.f, 0.f);
#pragma unroll
                    for (int i = 0; i < NSEG - 1; ++i) if (i < seg) { const float nr = T.ta[2] * hr - T.ta[3] * hi + e[i].x, ni = T.ta[2] * hi + T.ta[3] * hr + e[i].y; hr = nr; hi = ni; } }
#pragma unroll 1
                for (int blk = 0; blk < SEGB; ++blk) { u32x4 cur[2] = {pre[0], pre[1]};
                    if (blk + 1 < SEGB) ssm_stage_load(a, r0 + (blk + 1) * SBLK, SBLK, gq, pre);
                    ssm_unit<true>(a, lds, T, cur, l, r0 + blk * SBLK, SBLK, gq, hr, hi, wave); }
                if (seg == NSEG - 1) { const size_t so = ((size_t)l * NBATCH + b) * NG * NP + g * NP + lane; a.out[O_HRP + so] = hr; a.out[O_HIP + so] = hi; } }
            for (int v = bx; v < DEC_B * 4; v += G) { const int gq = v & 3, b = v >> 2; const int lane = opq(threadIdx.x) & 63, g = gq * 8 + wave;
                const size_t so = ((size_t)l * DEC_B + b) * NG * NP + g * NP + lane;
                ssm_stage_load(a, (size_t)NTOK_P + b * DEC_T, DEC_T, gq, pre);
                float hr = a.in[I_SR][so], hi = a.in[I_SI][so];
                ssm_unit<true>(a, lds, T, pre, l, (size_t)NTOK_P + b * DEC_T, DEC_T, gq, hr, hi, wave);
                a.out[O_HRS + so] = hr; a.out[O_HIS + so] = hi; } }
        GRID_BAR();
        }
        { pg8::Gemm g{ssmy, Wl + W_GLU, NTOK_P, 512, 512}; pg8::StaticOrder S; S.init(NTOK_P, 512, G, bx); EpiGlu E{ssmy, ssmg, a.in[I_BGLU] + l * 512};
          pg8::gemm_phase<EpiGlu, pg8::StaticOrder, true, true>(lds, g, S, E);
          { pg8::Gemm g1{bufA, Wl + W_IN + (size_t)(INC - 256) * DM, NTOK_P, 256, DM}; pg8::StaticOrder S1; S1.init(NTOK_P, 256, G, (bx + G - 128) % G); EpiIn E1{Z, ss1, a.in[I_BG] + l * 2048, INC / 256 - 1};
            pg8::gemm_phase<EpiIn, pg8::StaticOrder, true, true>(lds, g1, S1, E1); }
          skinny_gemm<2>(lds, ssmy, Wl + W_GLU, 512, 512, E, 192); }
        GRID_BAR();
        { pg8::Gemm g{attn, Wl + W_AO, NTOK_P, DM, 512}; pg8::StaticOrder S; S.init(NTOK_P, DM, G, bx); EpiMix<false> E{Z + ZG, mixed};
          pg8::gemm_phase<EpiMix<false>, pg8::StaticOrder, true, true>(lds, g, S, E);
          skinny_gemm<2>(lds, attn, Wl + W_AO, DM, 512, E, 0); }
        { pg8::Gemm g{ssmg, Wl + W_SO, NTOK_P, DM, 512}; pg8::StaticOrder S; S.init(NTOK_P, DM, G, bx); EpiMix<true> E{Z + ZG + DM, mixed};
          pg8::gemm_phase<EpiMix<true>, pg8::StaticOrder, true, true>(lds, g, S, E);
          skinny_gemm<2>(lds, ssmg, Wl + W_SO, DM, 512, E, 0); }
        GRID_BAR();
        { pg8::Gemm g{mixed, Wl + W_OUT, NTOK_P, DM, DM}; pg8::StaticOrder S; S.init(NTOK_P, DM, G, bx);
          EpiRes E{bufA, xb2, nullptr, ss2};
          pg8::gemm_phase<EpiRes, pg8::StaticOrder, true, true>(lds, g, S, E);
          skinny_gemm<2>(lds, mixed, Wl + W_OUT, DM, DM, E, 0); }
        GRID_BAR();
        { pg8::Gemm g{xb2, Wl + W_UP, NTOK_P, FF, DM}; pg8::StaticOrder S; S.init(NTOK_P, FF, G, bx); EpiUp E{H, ss2};
          pg8::gemm_phase<EpiUp, pg8::StaticOrder, true, true>(lds, g, S, E);
          skinny_gemm<4>(lds, xb2, Wl + W_UP, FF, DM, E, 0); }
        GRID_BAR();
        { pg8::Gemm g{H, Wl + W_DN, NTOK_P, DM, FF}; pg8::StaticOrder S; S.init(NTOK_P, DM, G, bx);
          EpiRes E{xb2, l == 0 ? bufA : nullptr, l == 0 ? nullptr : a.out, l == 0 ? ss1n : nullptr};
          pg8::gemm_phase<EpiRes, pg8::StaticOrder, true, true>(lds, g, S, E);
          skinny_gemm<2>(lds, H, Wl + W_DN, DM, FF, E, 0); }
        if (l == 0) GRID_BAR();
    }
}

extern "C" void kernel_launch(void* const* d_in, const int* in_sizes, int n_in, void* d_out, int out_size, void* d_ws, size_t ws_size, hipStream_t stream) {
    static int grid = 0;
    if (grid == 0) {
        if (n_in != 28 || (size_t)out_size != O_END || ws_size < WS_END) { fprintf(stderr, "kernel_launch: unexpected shapes n_in %d out %d ws %zu\n", n_in, out_size, ws_size); grid = -1; return; }
        int dev = 0, cus = 0, per_cu = 0;
        (void)hipGetDevice(&dev);
        (void)hipDeviceGetAttribute(&cus, hipDeviceAttributeMultiprocessorCount, dev);
        (void)hipFuncSetAttribute((const void*)mk_fwd, hipFuncAttributeMaxDynamicSharedMemorySize, LDS_BYTES);
        (void)hipOccupancyMaxActiveBlocksPerMultiprocessor(&per_cu, (const void*)mk_fwd, 512, LDS_BYTES);
        if (per_cu < 1) { fprintf(stderr, "kernel_launch: occupancy query reports %d blocks per CU\n", per_cu); grid = -1; return; }
        grid = cus & ~3;
    }
    if (grid < 0) return;
    Args a{};
    for (int i = 0; i < 28; ++i) a.in[i] = (const float*)d_in[i];
    a.out = (float*)d_out; a.ws = (unsigned char*)d_ws;
    void* args[] = {&a};
    hipError_t e = hipLaunchCooperativeKernel((const void*)mk_fwd, dim3(grid), dim3(512), args, LDS_BYTES, stream);
    if (e != hipSuccess) fprintf(stderr, "cooperative launch failed: %s (grid %d)\n", hipGetErrorString(e), grid);
}
```

```cpp
#include <hip/hip_runtime.h>
#include <hip/hip_cooperative_groups.h>
#include <cstdio>
#include <cstdint>
namespace cg = cooperative_groups;
namespace pg8 {
#define PG8_LAS __attribute__((address_space(3)))
typedef unsigned short bf16_t;
typedef short bf16x8 __attribute__((ext_vector_type(8)));
typedef float f32x4 __attribute__((ext_vector_type(4)));
typedef unsigned u32x4 __attribute__((ext_vector_type(4)));
constexpr int BM = 256, BK = 64, HALF = 128, HTB = HALF * BK * 2  , STAGE_BYTES = 8 * HTB, NXCD = 8, WGM = 8;

__host__ __device__ __forceinline__ int lds_byte(int r, int c) { const int st = (r >> 4) * 2 + (c >> 5), rr = r & 15, cc = c & 31, ob = rr * 64 + cc * 2; return st * 1024 + (ob ^ (((ob >> 9) & 1) << 5)); }
__host__ __device__ __forceinline__ void stage_rc(int b, int& R, int& C) { const int st = b / 1024, sb = b % 1024, swz = sb ^ (((sb >> 9) & 1) << 5); R = (st >> 1) * 16 + swz / 64; C = (st & 1) * 32 + (swz % 64) / 2; }
__host__ __device__ __forceinline__ int perm32(int rho) { const int n = rho >> 4, i = rho & 15; return 8 * (i >> 2) + 4 * n + (i & 3); }

struct Unit { int pm, pn; };
struct Gemm { const bf16_t* A; const bf16_t* Bt; int M, N, K; };

struct StaticOrder {
    int nM, nN, nwg, G, c;
    __host__ __device__ void init(int M, int N, int G_, int c_) { nM = M / BM; nN = N / BM; nwg = nM * nN; G = G_; c = c_; }
    __host__ __device__ bool next(int i, Unit& u) const {
        const long L = (long)i * G + c; if (L >= nwg) return false;
        int wgid = (int)L; { const int q = nwg / NXCD, r = nwg % NXCD, xcd = wgid % NXCD, off = wgid / NXCD; wgid = (xcd < r ? xcd * (q + 1) : r * (q + 1) + (xcd - r) * q) + off; }
        const int nig = WGM * nN, gid = wgid / nig, fm = gid * WGM, gsz = (nM - fm) < WGM ? (nM - fm) : WGM;
        u.pm = fm + ((wgid % nig) % gsz); u.pn = (wgid % nig) / gsz; return true;
    }
    __device__ __forceinline__ void a_ready(const Unit&) const {}
    __device__ __forceinline__ void done(const Unit&) const {}
};
__device__ __forceinline__ unsigned cvt_pk_bf16(float lo, float hi) { unsigned r; asm volatile("v_cvt_pk_bf16_f32 %0, %1, %2" : "=v"(r) : "v"(lo), "v"(hi)); return r; }
typedef float f32x2 __attribute__((ext_vector_type(2)));
template <class Epi, class Sched, bool ALIGN_EPI = false, bool SP2 = false>
__device__ __forceinline__ void gemm_phase(PG8_LAS unsigned char* lds, const Gemm g, const Sched& S, const Epi& E) {
    int tid_ = threadIdx.x; asm volatile("" : "+v"(tid_));
    const int tid = tid_, wid = __builtin_amdgcn_readfirstlane(tid >> 6), lane = tid & 63, wr = wid >> 2, wc = wid & 3, fr = lane & 15, fq = lane >> 4;
    const int K = g.K, nt = K / BK;
    unsigned voffA[2], voffB[2];
#pragma unroll
    for (int i = 0; i < 2; ++i) { int R, C; stage_rc(tid * 16 + i * 8192, R, C); const int Rb = Epi::PERM ? ((R & ~31) + perm32(R & 31)) : R;
        voffA[i] = (unsigned)(R * K + C) * 2u; voffB[i] = (unsigned)(Rb * K + C) * 2u; }
    const size_t kstep = (size_t)(BK * 2);
    const size_t hstep = (size_t)HALF * K * 2;
    const size_t tstep = 2 * hstep;
    const unsigned ldsw = (unsigned)wid * 1024u;
    const int aoff = lds_byte(wr * 64 + fr, fq * 8), boff = lds_byte(wc * 32 + fr, fq * 8);
#define PG8_SA(b, h) (((b) * 2 + (h)) * HTB)
#define PG8_SB(b, h) ((4 + (b) * 2 + (h)) * HTB)
#define PG8_STAGE(bufoff, gbase, voff) do { _Pragma("unroll") for (int _i = 0; _i < 2; ++_i) \
        __builtin_amdgcn_global_load_lds((const unsigned*)((const char*)(gbase) + (voff)[_i]), (PG8_LAS unsigned*)(lds + (bufoff) + ldsw + _i * 8192), 16, 0, 0); } while (0)
#define PG8_LDA(dst, b, h) do { _Pragma("unroll") for (int m = 0; m < 4; ++m) _Pragma("unroll") for (int k = 0; k < 2; ++k) dst[m][k] = *(const PG8_LAS bf16x8*)(lds + PG8_SA(b, h) + aoff + m * 2048 + k * 1024); } while (0)
#define PG8_LDB(dst, b, h) do { _Pragma("unroll") for (int n = 0; n < 2; ++n) _Pragma("unroll") for (int k = 0; k < 2; ++k) dst[n][k] = *(const PG8_LAS bf16x8*)(lds + PG8_SB(b, h) + boff + n * 2048 + k * 1024); } while (0)
#define PG8_MMA(ai, bj, At, Bt) do { __builtin_amdgcn_s_setprio(1); _Pragma("unroll") for (int m = 0; m < 4; ++m) _Pragma("unroll") for (int n = 0; n < 2; ++n) _Pragma("unroll") for (int k = 0; k < 2; ++k) \
        acc[ai][bj][m][n] = __builtin_amdgcn_mfma_f32_16x16x32_bf16(Bt[n][k], At[m][k], acc[ai][bj][m][n], 0, 0, 0); __builtin_amdgcn_s_setprio(0); } while (0)
#define PG8_WAIT_V(n) asm volatile("s_waitcnt vmcnt(" #n ")" ::: "memory")
#define PG8_WAIT_L(n) asm volatile("s_waitcnt lgkmcnt(" #n ")" ::: "memory")
#define PG8_BAR __builtin_amdgcn_s_barrier()
#define PG8_SCHED __builtin_amdgcn_sched_barrier(0)
    Unit cur, nxt; int ui = 0;
    if (!S.next(0, cur)) return;
    f32x4 acc[2][2][4][2];
#pragma unroll
    for (int a = 0; a < 2; ++a)
#pragma unroll
        for (int b = 0; b < 2; ++b)
#pragma unroll
            for (int m = 0; m < 4; ++m)
#pragma unroll
                for (int n = 0; n < 2; ++n) acc[a][b][m][n] = (f32x4){0.f, 0.f, 0.f, 0.f};
    bf16x8 At[4][2], B0[2][2], B1[2][2];
    const char* cA = (const char*)g.A + (size_t)cur.pm * tstep; const char* cB = (const char*)g.Bt + (size_t)cur.pn * tstep;
    S.a_ready(cur);
    if constexpr (SP2) {
        PG8_STAGE(PG8_SB(0, 0), cB, voffB); PG8_STAGE(PG8_SB(0, 1), cB + hstep, voffB); PG8_STAGE(PG8_SA(0, 0), cA, voffA); PG8_STAGE(PG8_SA(0, 1), cA + hstep, voffA);
        if (wr == 1) PG8_BAR;
        PG8_WAIT_V(2); PG8_BAR;
        PG8_STAGE(PG8_SB(1, 0), cB + kstep, voffB); PG8_STAGE(PG8_SA(1, 0), cA + kstep, voffA); PG8_STAGE(PG8_SB(1, 1), cB + hstep + kstep, voffB);
        PG8_WAIT_V(6); PG8_BAR;
    } else {
        PG8_STAGE(PG8_SB(0, 0), cB, voffB); PG8_STAGE(PG8_SA(0, 0), cA, voffA); PG8_STAGE(PG8_SB(0, 1), cB + hstep, voffB); PG8_STAGE(PG8_SA(0, 1), cA + hstep, voffA);
        if (wr == 1) PG8_BAR;
        PG8_WAIT_V(4); PG8_BAR;
        PG8_STAGE(PG8_SB(1, 0), cB + kstep, voffB); PG8_STAGE(PG8_SA(1, 0), cA + kstep, voffA); PG8_STAGE(PG8_SB(1, 1), cB + hstep + kstep, voffB);
        PG8_WAIT_V(6); PG8_BAR;
    }
    for (;;) {
        const bool has_next = S.next(ui + 1, nxt);
        const char* nA = has_next ? (const char*)g.A + (size_t)nxt.pm * tstep : cA; const char* nB = has_next ? (const char*)g.Bt + (size_t)nxt.pn * tstep : cB;
        for (int t = 0; t < nt; t += 2) {
            const bool last = (t == nt - 2);
            const char* a1 = cA + (size_t)(t + 1) * kstep;
            const char* a2 = last ? nA : cA + (size_t)(t + 2) * kstep; const char* b2 = last ? nB : cB + (size_t)(t + 2) * kstep;
            const char* a3 = a2 + kstep; const char* b3 = b2 + kstep;
            if (last && has_next) S.a_ready(nxt);
            if constexpr (SP2) {
            PG8_LDB(B0, 0, 0); PG8_LDB(B1, 0, 1); PG8_SCHED; PG8_LDA(At, 0, 0); PG8_STAGE(PG8_SA(1, 1), a1 + hstep, voffA);
            PG8_WAIT_V(8); PG8_WAIT_L(0); PG8_BAR; PG8_MMA(0, 0, At, B0); PG8_MMA(0, 1, At, B1); PG8_BAR; PG8_SCHED;
            PG8_LDA(At, 0, 1); PG8_STAGE(PG8_SB(0, 0), b2, voffB); PG8_STAGE(PG8_SB(0, 1), b2 + hstep, voffB); PG8_STAGE(PG8_SA(0, 0), a2, voffA);
            PG8_WAIT_V(8); PG8_WAIT_L(0); PG8_BAR; PG8_MMA(1, 0, At, B0); PG8_MMA(1, 1, At, B1); PG8_BAR; PG8_SCHED;
            PG8_LDB(B0, 1, 0); PG8_LDB(B1, 1, 1); PG8_SCHED; PG8_LDA(At, 1, 0); PG8_STAGE(PG8_SA(0, 1), a2 + hstep, voffA);
            PG8_WAIT_V(8); PG8_WAIT_L(0); PG8_BAR; PG8_MMA(0, 0, At, B0); PG8_MMA(0, 1, At, B1); PG8_BAR; PG8_SCHED;
            PG8_LDA(At, 1, 1); PG8_STAGE(PG8_SB(1, 0), b3, voffB); PG8_STAGE(PG8_SB(1, 1), b3 + hstep, voffB); PG8_STAGE(PG8_SA(1, 0), a3, voffA);
            PG8_WAIT_V(8); PG8_WAIT_L(0); PG8_BAR; PG8_MMA(1, 0, At, B0); PG8_MMA(1, 1, At, B1); PG8_BAR; PG8_SCHED;
            } else {
            PG8_LDB(B0, 0, 0); PG8_SCHED; PG8_LDA(At, 0, 0); PG8_STAGE(PG8_SA(1, 1), a1 + hstep, voffA);
            PG8_WAIT_L(8); PG8_BAR; PG8_WAIT_L(0); PG8_MMA(0, 0, At, B0); PG8_BAR; PG8_SCHED;
            PG8_LDB(B1, 0, 1); PG8_STAGE(PG8_SB(0, 0), b2, voffB);
            PG8_BAR; PG8_WAIT_L(0); PG8_MMA(0, 1, At, B1); PG8_BAR;
            PG8_LDA(At, 0, 1); PG8_STAGE(PG8_SA(0, 0), a2, voffA);
            PG8_BAR; PG8_WAIT_L(0); PG8_MMA(1, 0, At, B0); PG8_BAR; PG8_SCHED;
            PG8_STAGE(PG8_SB(0, 1), b2 + hstep, voffB);
            PG8_WAIT_V(6); PG8_BAR; PG8_MMA(1, 1, At, B1); PG8_BAR;
            PG8_LDB(B0, 1, 0); PG8_SCHED; PG8_LDA(At, 1, 0); PG8_STAGE(PG8_SA(0, 1), a2 + hstep, voffA);
            PG8_WAIT_L(8); PG8_BAR; PG8_WAIT_L(0); PG8_MMA(0, 0, At, B0); PG8_BAR; PG8_SCHED;
            PG8_LDB(B1, 1, 1); PG8_STAGE(PG8_SB(1, 0), b3, voffB);
            PG8_BAR; PG8_WAIT_L(0); PG8_MMA(0, 1, At, B1); PG8_BAR;
            PG8_LDA(At, 1, 1); PG8_STAGE(PG8_SA(1, 0), a3, voffA);
            PG8_BAR; PG8_WAIT_L(0); PG8_MMA(1, 0, At, B0); PG8_BAR; PG8_SCHED;
            PG8_STAGE(PG8_SB(1, 1), b3 + hstep, voffB);
            PG8_WAIT_V(6); PG8_BAR; PG8_MMA(1, 1, At, B1); PG8_BAR;
            }
        }
        if constexpr (ALIGN_EPI) { if (wr == 0) PG8_BAR; }
        if constexpr (!Epi::AFTER_DRAIN) { E(acc, cur, wr, wc, fr, fq); S.done(cur); }
        if (!has_next) break;
#pragma unroll
        for (int a = 0; a < 2; ++a)
#pragma unroll
            for (int b = 0; b < 2; ++b)
#pragma unroll
                for (int m = 0; m < 4; ++m)
#pragma unroll
                    for (int n = 0; n < 2; ++n) acc[a][b][m][n] = (f32x4){0.f, 0.f, 0.f, 0.f};
        cur = nxt; cA = nA; cB = nB; ++ui;
        if constexpr (ALIGN_EPI) { if (wr == 1) PG8_BAR; }
    }
    PG8_WAIT_V(0);
    if constexpr (!ALIGN_EPI) { if (wr == 0) PG8_BAR; }
    PG8_BAR;
    if constexpr (Epi::AFTER_DRAIN) { E.fused(acc, cur, wr, wc, fr, fq, lds, wid, lane); S.done(cur); }
#undef PG8_SA
#undef PG8_SB
#undef PG8_STAGE
#undef PG8_LDA
#undef PG8_LDB
#undef PG8_MMA
#undef PG8_WAIT_V
#undef PG8_WAIT_L
#undef PG8_BAR
#undef PG8_SCHED
}
}
using pg8::bf16_t; using pg8::bf16x8; using pg8::f32x4; using pg8::u32x4; using pg8::Unit;
#define LAS __attribute__((address_space(3)))
typedef unsigned u32x2 __attribute__((ext_vector_type(2)));

constexpr int DM = 1024, SEQ = 2048, NBATCH = 8, DEC_B = 128, DEC_T = 4, WIN = 128;
constexpr int NTOK_P = NBATCH * SEQ, NTOK_S = DEC_B * DEC_T, MTOK = NTOK_P + NTOK_S;
constexpr int INC = 3328, FF = 4096, NG = 32, NP = 64, GC = 16;
constexpr int ZQ = 0, ZK = 512, ZV = 640, ZU = 768, ZG = 1280;
constexpr int SBLK = 64, SEGB = 4, NSEG = SEQ / (SBLK * SEGB);
constexpr float EPS = 1e-6f, LOG2E = 1.4426950408889634f;
constexpr size_t MiB = 1u << 20;
constexpr size_t WS_SS = 1 * MiB, WS_TA = 1 * MiB + 512 * 1024, WS_TC = 1 * MiB + 640 * 1024, WS_TB = 2 * MiB;
constexpr size_t WS_W = 3 * MiB, WS_A = 57 * MiB, WS_B = 90 * MiB, WS_C = 123 * MiB, WS_END = 255 * MiB;
constexpr size_t W_IN = 0, W_GLU = W_IN + (size_t)INC * DM, W_AO = W_GLU + 512 * 512, W_SO = W_AO + 1024 * 512, W_OUT = W_SO + 1024 * 512,
                 W_UP = W_OUT + 1024 * 1024, W_DN = W_UP + (size_t)FF * DM, W_LAYER = W_DN + (size_t)FF * DM;
static_assert(WS_W + 2 * W_LAYER * 2 <= WS_A, "weights fit");
constexpr size_t HALFROWS = (size_t)MTOK * 512 * 2;
constexpr size_t ZBYTES = (size_t)MTOK * INC * 2;
static_assert(ZBYTES + HALFROWS + 4 * MiB <= WS_END - WS_C && (size_t)MTOK * FF * 2 <= WS_END - WS_C, "region C");
constexpr size_t O_YP = 0, O_YS = (size_t)NTOK_P * DM, O_KP = O_YS + (size_t)NTOK_S * DM, O_VP = O_KP + 2 * 8 * 128 * 128, O_HRP = O_VP + 2 * 8 * 128 * 128,
                 O_HIP = O_HRP + 2 * 8 * 32 * 64, O_KS = O_HIP + 2 * 8 * 32 * 64, O_VS = O_KS + (size_t)2 * 128 * 128 * 128, O_HRS = O_VS + (size_t)2 * 128 * 128 * 128,
                 O_HIS = O_HRS + 2 * 128 * 32 * 64, O_END = O_HIS + 2 * 128 * 32 * 64;
constexpr int LDS_BYTES = 147456;

__device__ __forceinline__ float bf2f(unsigned short b) { return __uint_as_float(((unsigned)b) << 16); }
__device__ __forceinline__ float bflo(unsigned w) { return __uint_as_float(w << 16); }
__device__ __forceinline__ float bfhi(unsigned w) { return __uint_as_float(w & 0xffff0000u); }
__device__ __forceinline__ unsigned pk2(float lo, float hi) { return pg8::cvt_pk_bf16(lo, hi); }
__device__ __forceinline__ unsigned short f2bf(float f) { return (unsigned short)(pg8::cvt_pk_bf16(f, 0.f) & 0xffffu); }
__device__ __forceinline__ float sigm(float x) { return __builtin_amdgcn_rcpf(1.f + __builtin_amdgcn_exp2f(-LOG2E * x)); }
__device__ __forceinline__ float gelu_tanh(float y) { const float y2 = y * y, t = y * (-2.f * 0.7978845608028654f * LOG2E - (2.f * 0.7978845608028654f * 0.044715f * LOG2E) * y2);
    return y * __builtin_amdgcn_rcpf(1.f + __builtin_amdgcn_exp2f(t)); }
__device__ __forceinline__ void unpack8(const u32x4 w, float (&f)[8]) { f[0] = bflo(w.x); f[1] = bfhi(w.x); f[2] = bflo(w.y); f[3] = bfhi(w.y); f[4] = bflo(w.z); f[5] = bfhi(w.z); f[6] = bflo(w.w); f[7] = bfhi(w.w); }
__device__ __forceinline__ int opq(int v) { asm volatile("" : "+v"(v)); return v; }
__device__ __forceinline__ float wave_sum(float v) {
#pragma unroll
    for (int o = 1; o < 64; o <<= 1) v += __shfl_xor(v, o);
    return v;
}

struct EpiIn {
    static constexpr bool PERM = true, AFTER_DRAIN = false;
    bf16_t* Z; const float* ss; const float* bgate; int pn0;
    struct Pre { float ssv; f32x4 b; };
    __device__ __forceinline__ void prefetch4(int row, int col, Pre& p) const { p.ssv = ss[row]; p.b = col >= ZG ? *(const f32x4*)(bgate + (col - ZG)) : (f32x4){0.f, 0.f, 0.f, 0.f}; }
    __device__ __forceinline__ void apply4(int row, int col, f32x4 v, const Pre& p) const {
        const float rs = rsqrtf(p.ssv * (1.f / DM) + EPS); v = v * rs;
        if (col >= ZG) { const f32x4 b = p.b; v = (f32x4){sigm(v[0] + b[0]), sigm(v[1] + b[1]), sigm(v[2] + b[2]), sigm(v[3] + b[3])}; }
        u32x2 w; w.x = pk2(v[0], v[1]); w.y = pk2(v[2], v[3]); *(u32x2*)(Z + (size_t)row * INC + col) = w;
    }
    __device__ __forceinline__ void operator()(const f32x4 (&acc)[2][2][4][2], const Unit& u, int wr, int wc, int fr, int fq) const {
        const int row0 = u.pm * 256 + wr * 64 + fr, col0 = (u.pn + pn0) * 256 + wc * 32 + 8 * fq; const bool gate = u.pn + pn0 >= 5;
        f32x4 bv[2][2];
#pragma unroll
        for (int bj = 0; bj < 2; ++bj)
#pragma unroll
            for (int n = 0; n < 2; ++n) bv[bj][n] = gate ? *(const f32x4*)(bgate + (col0 - ZG) + bj * 128 + 4 * n) : (f32x4){0.f, 0.f, 0.f, 0.f};
        float rsv[2][4];
#pragma unroll
        for (int ai = 0; ai < 2; ++ai)
#pragma unroll
            for (int m = 0; m < 4; ++m) rsv[ai][m] = ss[row0 + ai * 128 + m * 16];
        __builtin_amdgcn_sched_barrier(0);
#pragma unroll
        for (int ai = 0; ai < 2; ++ai)
#pragma unroll
            for (int m = 0; m < 4; ++m) { const int row = row0 + ai * 128 + m * 16; const float rs = rsqrtf(rsv[ai][m] * (1.f / DM) + EPS); bf16_t* rowp = Z + (size_t)row * INC + col0;
#pragma unroll
                for (int bj = 0; bj < 2; ++bj) { f32x4 v0 = acc[ai][bj][m][0] * rs + bv[bj][0], v1 = acc[ai][bj][m][1] * rs + bv[bj][1];
                    if (gate) { v0 = (f32x4){sigm(v0[0]), sigm(v0[1]), sigm(v0[2]), sigm(v0[3])}; v1 = (f32x4){sigm(v1[0]), sigm(v1[1]), sigm(v1[2]), sigm(v1[3])}; }
                    u32x4 w; w.x = pk2(v0[0], v0[1]); w.y = pk2(v0[2], v0[3]); w.z = pk2(v1[0], v1[1]); w.w = pk2(v1[2], v1[3]);
                    *(u32x4*)(rowp + bj * 128) = w; } }
    }
};
struct EpiGlu {
    static constexpr bool PERM = true, AFTER_DRAIN = false;
    const bf16_t* Y; bf16_t* O; const float* b;
    struct Pre { u32x2 yw; f32x4 bb; };
    __device__ __forceinline__ void prefetch4(int row, int col, Pre& p) const { p.yw = *(const u32x2*)(Y + (size_t)row * 512 + col); p.bb = *(const f32x4*)(b + col); }
    __device__ __forceinline__ void apply4(int row, int col, f32x4 v, const Pre& p) const {
        const u32x2 yw = p.yw; const f32x4 bb = p.bb;
        u32x2 w; w.x = pk2(bflo(yw.x) * sigm(v[0] + bb[0]), bfhi(yw.x) * sigm(v[1] + bb[1])); w.y = pk2(bflo(yw.y) * sigm(v[2] + bb[2]), bfhi(yw.y) * sigm(v[3] + bb[3]));
        *(u32x2*)(O + (size_t)row * 512 + col) = w;
    }
    __device__ __forceinline__ void operator()(const f32x4 (&acc)[2][2][4][2], const Unit& u, int wr, int wc, int fr, int fq) const {
        const int row0 = u.pm * 256 + wr * 64 + fr, col0 = u.pn * 256 + wc * 32 + 8 * fq;
        f32x4 bv[2][2];
#pragma unroll
        for (int bj = 0; bj < 2; ++bj)
#pragma unroll
            for (int n = 0; n < 2; ++n) bv[bj][n] = *(const f32x4*)(b + col0 + bj * 128 + 4 * n);
#pragma unroll
        for (int ai = 0; ai < 2; ++ai) {
            u32x4 yraw[4][2];
#pragma unroll
            for (int m = 0; m < 4; ++m)
#pragma unroll
                for (int bj = 0; bj < 2; ++bj) yraw[m][bj] = *(const u32x4*)(Y + (size_t)(row0 + ai * 128 + m * 16) * 512 + col0 + bj * 128);
            __builtin_amdgcn_sched_barrier(0);
#pragma unroll
            for (int m = 0; m < 4; ++m) { const size_t off = (size_t)(row0 + ai * 128 + m * 16) * 512 + col0;
#pragma unroll
                for (int bj = 0; bj < 2; ++bj) { const f32x4 v0 = acc[ai][bj][m][0] + bv[bj][0], v1 = acc[ai][bj][m][1] + bv[bj][1];
                    float y[8]; unpack8(yraw[m][bj], y);
                    u32x4 w; w.x = pk2(y[0] * sigm(v0[0]), y[1] * sigm(v0[1])); w.y = pk2(y[2] * sigm(v0[2]), y[3] * sigm(v0[3]));
                    w.z = pk2(y[4] * sigm(v1[0]), y[5] * sigm(v1[1])); w.w = pk2(y[6] * sigm(v1[2]), y[7] * sigm(v1[3]));
                    *(u32x4*)(O + off + bj * 128) = w; } } }
    }
};
template <bool SECOND> struct EpiMix {
    static constexpr bool PERM = true, AFTER_DRAIN = false;
    const bf16_t* Zg; bf16_t* O;
    struct Pre { u32x2 gw, pw; };
    __device__ __forceinline__ void prefetch4(int row, int col, Pre& p) const { p.gw = *(const u32x2*)(Zg + (size_t)row * INC + col); if (SECOND) p.pw = *(const u32x2*)(O + (size_t)row * DM + col); }
    __device__ __forceinline__ void apply4(int row, int col, f32x4 v, const Pre& p) const {
        const u32x2 gw = p.gw; bf16_t* op = O + (size_t)row * DM + col;
        v = (f32x4){bflo(gw.x) * v[0], bfhi(gw.x) * v[1], bflo(gw.y) * v[2], bfhi(gw.y) * v[3]};
        if (SECOND) { const u32x2 pw = p.pw; v = v + (f32x4){bflo(pw.x), bfhi(pw.x), bflo(pw.y), bfhi(pw.y)}; }
        u32x2 w; w.x = pk2(v[0], v[1]); w.y = pk2(v[2], v[3]); *(u32x2*)op = w;
    }
    __device__ __forceinline__ void operator()(const f32x4 (&acc)[2][2][4][2], const Unit& u, int wr, int wc, int fr, int fq) const {
        const int row0 = u.pm * 256 + wr * 64 + fr, col0 = u.pn * 256 + wc * 32 + 8 * fq;
#pragma unroll
        for (int ai = 0; ai < 2; ++ai) {
            u32x4 graw[4][2], praw[4][2];
#pragma unroll
            for (int m = 0; m < 4; ++m)
#pragma unroll
                for (int bj = 0; bj < 2; ++bj) { const int row = row0 + ai * 128 + m * 16; graw[m][bj] = *(const u32x4*)(Zg + (size_t)row * INC + col0 + bj * 128);
                    if (SECOND) praw[m][bj] = *(const u32x4*)(O + (size_t)row * DM + col0 + bj * 128); }
            __builtin_amdgcn_sched_barrier(0);
#pragma unroll
            for (int m = 0; m < 4; ++m) { const int row = row0 + ai * 128 + m * 16;
#pragma unroll
                for (int bj = 0; bj < 2; ++bj) { const f32x4 a0 = acc[ai][bj][m][0], a1 = acc[ai][bj][m][1];
                    float g[8]; unpack8(graw[m][bj], g);
                    float v[8] = {g[0] * a0[0], g[1] * a0[1], g[2] * a0[2], g[3] * a0[3], g[4] * a1[0], g[5] * a1[1], g[6] * a1[2], g[7] * a1[3]};
                    bf16_t* op = O + (size_t)row * DM + col0 + bj * 128;
                    if (SECOND) { float p[8]; unpack8(praw[m][bj], p);
#pragma unroll
                        for (int k = 0; k < 8; ++k) v[k] += p[k]; }
                    u32x4 w; w.x = pk2(v[0], v[1]); w.y = pk2(v[2], v[3]); w.z = pk2(v[4], v[5]); w.w = pk2(v[6], v[7]);
                    *(u32x4*)op = w; } } }
    }
};
struct EpiRes {
    static constexpr bool PERM = true, AFTER_DRAIN = false;
    const bf16_t* base; bf16_t* XB; float* Xf; float* ss;
    struct Pre { u32x2 bw; };
    __device__ __forceinline__ void prefetch4(int row, int col, Pre& p) const { p.bw = *(const u32x2*)(base + (size_t)row * DM + col); }
    __device__ __forceinline__ void apply4(int row, int col, f32x4 v, const Pre& p) const {
        const size_t off = (size_t)row * DM + col; const u32x2 bw = p.bw;
        v = v + (f32x4){bflo(bw.x), bfhi(bw.x), bflo(bw.y), bfhi(bw.y)};
        if (Xf) *(f32x4*)(Xf + off) = v;
        if (XB) { u32x2 w; w.x = pk2(v[0], v[1]); w.y = pk2(v[2], v[3]); *(u32x2*)(XB + off) = w; }
        if (ss) { float sq = (v[0] * v[0] + v[1] * v[1]) + (v[2] * v[2] + v[3] * v[3]); sq += __shfl_xor(sq, 1); sq += __shfl_xor(sq, 2); sq += __shfl_xor(sq, 4); if ((threadIdx.x & 7) == 0) atomicAdd(ss + row, sq); }
    }
    __device__ __forceinline__ void operator()(const f32x4 (&acc)[2][2][4][2], const Unit& u, int wr, int wc, int fr, int fq) const {
        const int row0 = u.pm * 256 + wr * 64 + fr, col0 = u.pn * 256 + wc * 32 + 8 * fq;
#pragma unroll
        for (int ai = 0; ai < 2; ++ai) {
            u32x4 braw[4][2];
#pragma unroll
            for (int m = 0; m < 4; ++m)
#pragma unroll
                for (int bj = 0; bj < 2; ++bj) braw[m][bj] = *(const u32x4*)(base + (size_t)(row0 + ai * 128 + m * 16) * DM + col0 + bj * 128);
            __builtin_amdgcn_sched_barrier(0);
#pragma unroll
            for (int m = 0; m < 4; ++m) { const int row = row0 + ai * 128 + m * 16; const size_t off = (size_t)row * DM + col0; float sq = 0.f;
#pragma unroll
                for (int bj = 0; bj < 2; ++bj) { float b[8]; unpack8(braw[m][bj], b);
                    const f32x4 a0 = acc[ai][bj][m][0], a1 = acc[ai][bj][m][1];
                    const f32x4 v0 = (f32x4){b[0] + a0[0], b[1] + a0[1], b[2] + a0[2], b[3] + a0[3]}, v1 = (f32x4){b[4] + a1[0], b[5] + a1[1], b[6] + a1[2], b[7] + a1[3]};
                    sq += (v0[0] * v0[0] + v0[1] * v0[1]) + (v0[2] * v0[2] + v0[3] * v0[3]) + (v1[0] * v1[0] + v1[1] * v1[1]) + (v1[2] * v1[2] + v1[3] * v1[3]);
                    if (Xf) { *(f32x4*)(Xf + off + bj * 128) = v0; *(f32x4*)(Xf + off + bj * 128 + 4) = v1; }
                    if (XB) { u32x4 w; w.x = pk2(v0[0], v0[1]); w.y = pk2(v0[2], v0[3]); w.z = pk2(v1[0], v1[1]); w.w = pk2(v1[2], v1[3]); *(u32x4*)(XB + off + bj * 128) = w; } }
                if (ss) { sq += __shfl_xor(sq, 16); sq += __shfl_xor(sq, 32); if (fq == 0) atomicAdd(ss + row, sq); } } }
    }
};
struct EpiUp {
    static constexpr bool PERM = true, AFTER_DRAIN = false;
    bf16_t* H; const float* ss;
    struct Pre { float ssv; };
    __device__ __forceinline__ void prefetch4(int row, int col, Pre& p) const { p.ssv = ss[row]; }
    __device__ __forceinline__ void apply4(int row, int col, f32x4 v, const Pre& p) const {
        const float rs = rsqrtf(p.ssv * (1.f / DM) + EPS);
#pragma unroll
        for (int k = 0; k < 4; ++k) { const float t = fmaxf(v[k] * rs, 0.f); v[k] = t * t; }
        u32x2 w; w.x = pk2(v[0], v[1]); w.y = pk2(v[2], v[3]); *(u32x2*)(H + (size_t)row * FF + col) = w;
    }
    __device__ __forceinline__ void operator()(const f32x4 (&acc)[2][2][4][2], const Unit& u, int wr, int wc, int fr, int fq) const {
        const int row0 = u.pm * 256 + wr * 64 + fr, col0 = u.pn * 256 + wc * 32 + 8 * fq;
        float rsv[2][4];
#pragma unroll
        for (int ai = 0; ai < 2; ++ai)
#pragma unroll
            for (int m = 0; m < 4; ++m) rsv[ai][m] = ss[row0 + ai * 128 + m * 16];
        __builtin_amdgcn_sched_barrier(0);
#pragma unroll
        for (int ai = 0; ai < 2; ++ai)
#pragma unroll
            for (int m = 0; m < 4; ++m) { const int row = row0 + ai * 128 + m * 16; const float rs = rsqrtf(rsv[ai][m] * (1.f / DM) + EPS); bf16_t* rowp = H + (size_t)row * FF + col0;
#pragma unroll
                for (int bj = 0; bj < 2; ++bj) { f32x4 v0 = acc[ai][bj][m][0] * rs, v1 = acc[ai][bj][m][1] * rs;
#pragma unroll
                    for (int k = 0; k < 4; ++k) { const float a = fmaxf(v0[k], 0.f), b = fmaxf(v1[k], 0.f); v0[k] = a * a; v1[k] = b * b; }
                    u32x4 w; w.x = pk2(v0[0], v0[1]); w.y = pk2(v0[2], v0[3]); w.z = pk2(v1[0], v1[1]); w.w = pk2(v1[2], v1[3]);
                    *(u32x4*)(rowp + bj * 128) = w; } }
    }
};

template <int CT, class Epi> __device__ __forceinline__ void skinny_gemm(LAS unsigned char* lds, const bf16_t* A, const bf16_t* Bt, int N, int K, const Epi& E, int first) {
    const int tid = opq(threadIdx.x), lane = tid & 63, wave = __builtin_amdgcn_readfirstlane(tid >> 6), r = lane & 15, qd = lane >> 4;
    const int G = gridDim.x, nunits = 8 * (N / (16 * CT)), kw = K / 8, nsteps = kw / 32;
    LAS float* red = (LAS float*)lds;
    for (int u = (int)((blockIdx.x + G - first % G) % G); u < nunits; u += G) {
        const int mt = u & 7, nt = u >> 3;
        const bf16_t* ap = A + (size_t)(NTOK_P + mt * 64 + r) * K + wave * kw + 8 * qd;
        const bf16_t* bp = Bt + (size_t)(nt * 16 * CT + r) * K + wave * kw + 8 * qd;
        typename Epi::Pre pre[CT / 2];
#pragma unroll
        for (int e = 0; e < CT / 2; ++e) { const int idx = tid + e * 512; E.prefetch4(NTOK_P + mt * 64 + idx / (4 * CT), nt * 16 * CT + (idx % (4 * CT)) * 4, pre[e]); }
        f32x4 acc[4][CT];
#pragma unroll
        for (int rt = 0; rt < 4; ++rt)
#pragma unroll
            for (int ct = 0; ct < CT; ++ct) acc[rt][ct] = (f32x4){0.f, 0.f, 0.f, 0.f};
#define SKINNY_GROUP(GS, S0) do { bf16x8 af_[GS][4], bf_[GS][CT]; \
            _Pragma("unroll") for (int q_ = 0; q_ < GS; ++q_) { \
                _Pragma("unroll") for (int rt = 0; rt < 4; ++rt) af_[q_][rt] = *(const bf16x8*)(ap + (size_t)rt * 16 * K + ((S0) + q_) * 32); \
                _Pragma("unroll") for (int ct = 0; ct < CT; ++ct) bf_[q_][ct] = *(const bf16x8*)(bp + (size_t)ct * 16 * K + ((S0) + q_) * 32); } \
            __builtin_amdgcn_sched_barrier(0); \
            _Pragma("unroll") for (int q_ = 0; q_ < GS; ++q_) \
                _Pragma("unroll") for (int rt = 0; rt < 4; ++rt) \
                    _Pragma("unroll") for (int ct = 0; ct < CT; ++ct) acc[rt][ct] = __builtin_amdgcn_mfma_f32_16x16x32_bf16(bf_[q_][ct], af_[q_][rt], acc[rt][ct], 0, 0, 0); \
            __builtin_amdgcn_sched_barrier(0); } while (0)
        if (nsteps >= 4) {
#pragma unroll 1
            for (int s0 = 0; s0 < nsteps; s0 += 4) SKINNY_GROUP(4, s0);
        } else SKINNY_GROUP(2, 0);
#undef SKINNY_GROUP
#pragma unroll
        for (int rt = 0; rt < 4; ++rt)
#pragma unroll
            for (int ct = 0; ct < CT; ++ct) *(LAS f32x4*)(red + wave * (64 * 16 * CT) + (rt * 16 + r) * (16 * CT) + ct * 16 + 4 * qd) = acc[rt][ct];
        __syncthreads();
#pragma unroll
        for (int e = 0; e < CT / 2; ++e) { const int idx = tid + e * 512, row = idx / (4 * CT), c4 = idx % (4 * CT);
            f32x4 v = *(const LAS f32x4*)(red + row * (16 * CT) + c4 * 4);
#pragma unroll
            for (int w = 1; w < 8; ++w) v = v + *(const LAS f32x4*)(red + w * (64 * 16 * CT) + row * (16 * CT) + c4 * 4);
            E.apply4(NTOK_P + mt * 64 + row, nt * 16 * CT + c4 * 4, v, pre[e]); }
        __syncthreads();
    }
}

struct Args { const float* in[28]; float* out; unsigned char* ws; };
enum { I_XP = 0, I_XS, I_CK, I_CV, I_SR, I_SI, I_N1G, I_WIN, I_BG, I_QG, I_KG, I_SINK, I_LRE, I_LIM, I_LSTEP, I_BRE, I_BIM, I_CRE, I_CIM, I_DSK, I_WGLU, I_BGLU, I_WAO, I_WSO, I_WOUT, I_N2G, I_WUP, I_WDN };

struct TItem { const float* W; const float* gain; bf16_t* WT; int K, N, k0, n0; };
__device__ __forceinline__ TItem titem(const Args& a, int it) {
    constexpr int I0 = (DM / 64) * (INC / 256), I1 = (512 / 64) * (512 / 256), I2 = (512 / 64) * (1024 / 256), I3 = I2, I4 = (DM / 64) * (DM / 256), I5 = (DM / 64) * (FF / 256), I6 = (FF / 64) * (DM / 256);
    constexpr int IL = I0 + I1 + I2 + I3 + I4 + I5 + I6;
    const int l = it / IL; int r = it % IL; bf16_t* Wl = (bf16_t*)(a.ws + WS_W) + (size_t)l * W_LAYER; TItem t;
    if (r < I0) { t.W = a.in[I_WIN] + (size_t)l * DM * INC; t.gain = a.in[I_N1G] + l * DM; t.WT = Wl + W_IN; t.K = DM; t.N = INC; }
    else if ((r -= I0) < I1) { t.W = a.in[I_WGLU] + (size_t)l * 512 * 512; t.gain = nullptr; t.WT = Wl + W_GLU; t.K = 512; t.N = 512; }
    else if ((r -= I1) < I2) { t.W = a.in[I_WAO] + (size_t)l * 512 * 1024; t.gain = nullptr; t.WT = Wl + W_AO; t.K = 512; t.N = 1024; }
    else if ((r -= I2) < I3) { t.W = a.in[I_WSO] + (size_t)l * 512 * 1024; t.gain = nullptr; t.WT = Wl + W_SO; t.K = 512; t.N = 1024; }
    else if ((r -= I3) < I4) { t.W = a.in[I_WOUT] + (size_t)l * DM * DM; t.gain = nullptr; t.WT = Wl + W_OUT; t.K = DM; t.N = DM; }
    else if ((r -= I4) < I5) { t.W = a.in[I_WUP] + (size_t)l * DM * FF; t.gain = a.in[I_N2G] + l * DM; t.WT = Wl + W_UP; t.K = DM; t.N = FF; }
    else { r -= I5; t.W = a.in[I_WDN] + (size_t)l * FF * DM; t.gain = nullptr; t.WT = Wl + W_DN; t.K = FF; t.N = DM; }
    const int nblk = t.N / 256; t.k0 = 64 * (r / nblk); t.n0 = 256 * (r % nblk);
    return t;
}
constexpr int T_ITEMS = 2 * ((DM / 64) * (INC / 256) + (512 / 64) * (512 / 256) + 2 * (512 / 64) * (1024 / 256) + (DM / 64) * (DM / 256) + (DM / 64) * (FF / 256) + (FF / 64) * (DM / 256));
__device__ __forceinline__ void prologue(const Args& a, LAS unsigned char* lds, int tid, int wave, int lane) {
    unsigned char* ws = a.ws;
    const int gw = blockIdx.x * 8 + wave, NGW = gridDim.x * 8;
    {   constexpr int TS = 257; LAS float* tile = (LAS float*)lds;
        f32x4 v[8]; int it = blockIdx.x;
        if (it < T_ITEMS) { const TItem t = titem(a, it);
#pragma unroll
            for (int i = 0; i < 8; ++i) { v[i] = __builtin_nontemporal_load((const f32x4*)(t.W + (size_t)(t.k0 + 8 * wave + i) * t.N + t.n0 + 4 * lane)); if (t.gain) v[i] = v[i] * t.gain[t.k0 + 8 * wave + i]; } }
        for (; it < T_ITEMS; it += gridDim.x) {
            const TItem t = titem(a, it);
#pragma unroll
            for (int i = 0; i < 8; ++i) { LAS float* tp = tile + (8 * wave + i) * TS + 4 * lane; tp[0] = v[i][0]; tp[1] = v[i][1]; tp[2] = v[i][2]; tp[3] = v[i][3]; }
            __syncthreads();
            if (it + (int)gridDim.x < T_ITEMS) { const TItem tn = titem(a, it + gridDim.x);
#pragma unroll
                for (int i = 0; i < 8; ++i) { v[i] = __builtin_nontemporal_load((const f32x4*)(tn.W + (size_t)(tn.k0 + 8 * wave + i) * tn.N + tn.n0 + 4 * lane)); if (tn.gain) v[i] = v[i] * tn.gain[tn.k0 + 8 * wave + i]; } }
#pragma unroll
            for (int j = 0; j < 4; ++j) { const int q = tid + 512 * j, n = q >> 3, c = q & 7; const LAS float* s = tile + (8 * c) * TS + n;
                u32x4 o; o.x = pk2(s[0 * TS], s[1 * TS]); o.y = pk2(s[2 * TS], s[3 * TS]); o.z = pk2(s[4 * TS], s[5 * TS]); o.w = pk2(s[6 * TS], s[7 * TS]);
                *(u32x4*)(t.WT + (size_t)(t.n0 + n) * t.K + t.k0 + 8 * c) = o; }
            __syncthreads();
        }
    }
    float* ss = (float*)(ws + WS_SS); bf16_t* XB = (bf16_t*)(ws + WS_A);
    for (int m = gw; m < MTOK; m += NGW) {
        const float* src = (m < NTOK_P) ? a.in[I_XP] + (size_t)m * DM : a.in[I_XS] + (size_t)(m - NTOK_P) * DM;
        f32x4 v[4]; float s = 0.f;
#pragma unroll
        for (int j = 0; j < 4; ++j) { v[j] = __builtin_nontemporal_load((const f32x4*)src + lane + 64 * j); s += (v[j][0] * v[j][0] + v[j][1] * v[j][1]) + (v[j][2] * v[j][2] + v[j][3] * v[j][3]); }
        s = wave_sum(s);
#pragma unroll
        for (int j = 0; j < 4; ++j) { u32x2 w; w.x = pk2(v[j][0], v[j][1]); w.y = pk2(v[j][2], v[j][3]); *((u32x2*)(XB + (size_t)m * DM) + lane + 64 * j) = w; }
        if (lane == 0) ss[m] = s;
    }
    for (int i = blockIdx.x * 512 + tid; i < 3 * MTOK; i += gridDim.x * 512) ss[MTOK + i] = 0.f;
    for (int i = tid < 16 ? (int)blockIdx.x * 16 + tid : 2 * NG * NP; i < 2 * NG * NP; i += gridDim.x * 16) {
        const int l = i / (NG * NP), g = (i / NP) % NG, p = i % NP;
        const float lre = a.in[I_LRE][i], lim = a.in[I_LIM][i], step = expf(a.in[I_LSTEP][l * NG + g]);
        const float mag = expf(lre * step), ar = mag * cosf(lim * step), ai = mag * sinf(lim * step), den = lre * lre + lim * lim;
        const float cr = ((ar - 1.f) * lre + ai * lim) / den, ci = (ai * lre - (ar - 1.f) * lim) / den;
        float pr = ar, pi = ai;
#pragma unroll
        for (int k = 0; k < 8; ++k) { const float nr = pr * pr - pi * pi, ni = 2.f * pr * pi; pr = nr; pi = ni; }
        ((f32x4*)(ws + WS_TA))[i] = (f32x4){ar, ai, pr, pi};
        bf16_t* tbh = (bf16_t*)(ws + WS_TB) + (size_t)(l * NG + g) * 128 * GC;
        const float* bre = a.in[I_BRE] + (size_t)i * GC; const float* bim = a.in[I_BIM] + (size_t)i * GC;
#pragma unroll
        for (int c = 0; c < GC; c += 2) { const float br0 = bre[c], bi0 = bim[c], br1 = bre[c + 1], bi1 = bim[c + 1];
            *(unsigned*)(tbh + (2 * p) * GC + c) = pk2(cr * br0 - ci * bi0, cr * br1 - ci * bi1); *(unsigned*)(tbh + (2 * p + 1) * GC + c) = pk2(cr * bi0 + ci * br0, cr * bi1 + ci * br1); }
        bf16_t* tc = (bf16_t*)(ws + WS_TC) + (size_t)(l * NG + g) * GC * 128;
        const float* cre = a.in[I_CRE] + (size_t)(l * NG + g) * GC * NP; const float* cim = a.in[I_CIM] + (size_t)(l * NG + g) * GC * NP;
#pragma unroll
        for (int c = 0; c < GC; ++c) *(unsigned*)(tc + c * 128 + 2 * p) = pk2(cre[c * NP + p], -cim[c * NP + p]);
    }
}

__device__ __forceinline__ void attn_prompt_unit(const Args& a, LAS unsigned char* lds, int l, int b, int qb, int kvh, int tid) {
    constexpr int KST = 72, VST = 272;
    LAS bf16_t* Ks = (LAS bf16_t*)lds; LAS bf16_t* Vt = Ks + 256 * KST; LAS float* kmaxs = (LAS float*)(Vt + 64 * VST);
    const bf16_t* Z = (const bf16_t*)(a.ws + WS_C);
    const float* gk = a.in[I_KG] + l * 64; const float* gq = a.in[I_QG] + l * 64;
    const int wave = tid >> 6, lane = tid & 63, r = lane & 15, qd = lane >> 4, g = wave >> 1, qh = wave & 1, h = kvh * 4 + g;
    const size_t qrow0 = (size_t)b * SEQ + qb * WIN + qh * 64;
    u32x4 qraw[4][2];
#pragma unroll
    for (int qt = 0; qt < 4; ++qt) { const bf16_t* zq = Z + (qrow0 + qt * 16 + r) * INC + ZQ + h * 64 + 8 * qd; qraw[qt][0] = *(const u32x4*)zq; qraw[qt][1] = *(const u32x4*)(zq + 32); }
    f32x4 gkv[8], gqv[4];
#pragma unroll
    for (int c = 0; c < 8; ++c) gkv[c] = *(const f32x4*)(gk + (tid & 1) * 32 + 4 * c);
#pragma unroll
    for (int c = 0; c < 4; ++c) gqv[c] = *(const f32x4*)(gq + (c >> 1) * 32 + 8 * qd + 4 * (c & 1));
    {
        const int j = tid >> 1, half = tid & 1, pos = (qb - 1) * WIN + j; const bool valid = pos >= 0;
        float kf[32]; u32x4 vraw[4];
        if (valid) { const bf16_t* zr = Z + (size_t)(b * SEQ + pos) * INC + kvh * 64 + half * 32;
#pragma unroll
            for (int c = 0; c < 4; ++c) { float t8[8]; unpack8(*(const u32x4*)(zr + ZK + c * 8), t8);
#pragma unroll
                for (int k = 0; k < 8; ++k) kf[c * 8 + k] = t8[k];
                vraw[c] = *(const u32x4*)(zr + ZV + c * 8); }
        } else {
#pragma unroll
            for (int k = 0; k < 32; ++k) kf[k] = 0.f;
#pragma unroll
            for (int c = 0; c < 4; ++c) vraw[c] = (u32x4){0u, 0u, 0u, 0u}; }
        float sq = 0.f;
#pragma unroll
        for (int k = 0; k < 32; ++k) sq += kf[k] * kf[k];
        sq += __shfl_xor(sq, 1);
        const float rs = rsqrtf(sq * (1.f / 64.f) + EPS); float n2 = 0.f;
#pragma unroll
        for (int k = 0; k < 32; ++k) { kf[k] = kf[k] * rs * gkv[k >> 2][k & 3]; n2 += kf[k] * kf[k]; }
        n2 += __shfl_xor(n2, 1);
        { float wm = n2;
#pragma unroll
          for (int o = 1; o < 64; o <<= 1) wm = fmaxf(wm, __shfl_xor(wm, o));
          if (lane == 0) kmaxs[wave] = sqrtf(wm); }
#pragma unroll
        for (int c = 0; c < 4; ++c) { u32x4 w; w.x = pk2(kf[8 * c], kf[8 * c + 1]); w.y = pk2(kf[8 * c + 2], kf[8 * c + 3]); w.z = pk2(kf[8 * c + 4], kf[8 * c + 5]); w.w = pk2(kf[8 * c + 6], kf[8 * c + 7]);
            *(LAS u32x4*)(Ks + j * KST + half * 32 + c * 8) = w; }
#pragma unroll
        for (int c = 0; c < 4; ++c) { const unsigned w4[4] = {vraw[c].x, vraw[c].y, vraw[c].z, vraw[c].w};
#pragma unroll
            for (int k = 0; k < 4; ++k) { Vt[(half * 32 + c * 8 + 2 * k) * VST + j] = (bf16_t)(w4[k] & 0xffffu); Vt[(half * 32 + c * 8 + 2 * k + 1) * VST + j] = (bf16_t)(w4[k] >> 16); } }
        if (qb == SEQ / WIN - 1 && j >= WIN) {
            float* ko = a.out + O_KP + ((((size_t)l * NBATCH + b) * WIN + (j - WIN)) * 2 + kvh) * 64 + half * 32;
            float* vo = a.out + O_VP + ((((size_t)l * NBATCH + b) * WIN + (j - WIN)) * 2 + kvh) * 64 + half * 32;
#pragma unroll
            for (int c = 0; c < 8; ++c) *(f32x4*)(ko + 4 * c) = (f32x4){kf[4 * c], kf[4 * c + 1], kf[4 * c + 2], kf[4 * c + 3]};
#pragma unroll
            for (int c = 0; c < 4; ++c) { *(f32x4*)(vo + 8 * c) = (f32x4){bflo(vraw[c].x), bfhi(vraw[c].x), bflo(vraw[c].y), bfhi(vraw[c].y)}; *(f32x4*)(vo + 8 * c + 4) = (f32x4){bflo(vraw[c].z), bfhi(vraw[c].z), bflo(vraw[c].w), bfhi(vraw[c].w)}; }
        }
    }
    __syncthreads();
    float kmax = kmaxs[0];
#pragma unroll
    for (int w = 1; w < 8; ++w) kmax = fmaxf(kmax, kmaxs[w]);
    const float cs = 0.125f * LOG2E, sinkl = a.in[I_SINK][l * 8 + h] * LOG2E, slope = exp2f(-(float)(h + 1)) * LOG2E;
    bf16x8 qf[4][2]; float mref[4];
#pragma unroll
    for (int qt = 0; qt < 4; ++qt) {
        float x[16]; { float t8[8]; unpack8(qraw[qt][0], t8);
#pragma unroll
            for (int k = 0; k < 8; ++k) x[k] = t8[k];
            unpack8(qraw[qt][1], t8);
#pragma unroll
            for (int k = 0; k < 8; ++k) x[8 + k] = t8[k]; }
        float sq = 0.f;
#pragma unroll
        for (int k = 0; k < 16; ++k) sq += x[k] * x[k];
        sq += __shfl_xor(sq, 16); sq += __shfl_xor(sq, 32);
        const float rs = rsqrtf(sq * (1.f / 64.f) + EPS); float n2 = 0.f;
#pragma unroll
        for (int k = 0; k < 16; ++k) { x[k] = x[k] * rs * gqv[k >> 2][k & 3]; n2 += x[k] * x[k]; }
        n2 += __shfl_xor(n2, 16); n2 += __shfl_xor(n2, 32);
        mref[qt] = fmaxf(sinkl, sqrtf(n2) * kmax * cs);
#pragma unroll
        for (int s = 0; s < 2; ++s) { u32x4 w; w.x = pk2(x[8 * s] * cs, x[8 * s + 1] * cs); w.y = pk2(x[8 * s + 2] * cs, x[8 * s + 3] * cs); w.z = pk2(x[8 * s + 4] * cs, x[8 * s + 5] * cs); w.w = pk2(x[8 * s + 6] * cs, x[8 * s + 7] * cs);
            qf[qt][s] = __builtin_bit_cast(bf16x8, w); }
    }
    f32x4 O[4][4]; float lsum[4];
#pragma unroll
    for (int qt = 0; qt < 4; ++qt) { lsum[qt] = 0.f;
#pragma unroll
        for (int dt = 0; dt < 4; ++dt) O[qt][dt] = (f32x4){0.f, 0.f, 0.f, 0.f}; }
    const int base = r - 4 * qd;
#pragma unroll
    for (int qt = 0; qt < 4; ++qt) mref[qt] += slope * (float)base;
#pragma unroll 1
    for (int ks = (qb == 0 ? (4 - 2 * qh) : 0); ks < 6; ++ks) {
        const int J = qh * 64 + ks * 32, base2 = base - 32 * ks; const float sk = slope * (float)(32 * ks);
        bf16x8 kfr[2][2], vfr[4];
#pragma unroll
        for (int T = 0; T < 2; ++T)
#pragma unroll
            for (int s = 0; s < 2; ++s) kfr[T][s] = *(const LAS bf16x8*)(Ks + (J + 16 * T + r) * KST + 32 * s + 8 * qd);
#pragma unroll
        for (int dt = 0; dt < 4; ++dt) { const u32x2 lo = *(const LAS u32x2*)(Vt + (dt * 16 + r) * VST + J + 4 * qd), hi = *(const LAS u32x2*)(Vt + (dt * 16 + r) * VST + J + 16 + 4 * qd);
            vfr[dt] = __builtin_bit_cast(bf16x8, (u32x4){lo.x, lo.y, hi.x, hi.y}); }
#pragma unroll
        for (int qt = 0; qt < 4; ++qt) {
            if (ks * 32 + 31 >= qt * 16 && ks * 32 <= qt * 16 + 143) {
                f32x4 S[2];
#pragma unroll
                for (int T = 0; T < 2; ++T) { S[T] = __builtin_amdgcn_mfma_f32_16x16x32_bf16(kfr[T][0], qf[qt][0], (f32x4){0.f, 0.f, 0.f, 0.f}, 0, 0, 0); S[T] = __builtin_amdgcn_mfma_f32_16x16x32_bf16(kfr[T][1], qf[qt][1], S[T], 0, 0, 0); }
                const float mt = mref[qt] - sk; float p[2][4];
#pragma unroll
                for (int T = 0; T < 2; ++T)
#pragma unroll
                    for (int i = 0; i < 4; ++i) { const int cst = WIN + 16 * qt - 16 * T - i; const unsigned dist = (unsigned)(cst + base2);
                        const float e = __builtin_amdgcn_exp2f((S[T][i] - mt) - slope * (float)cst); p[T][i] = dist <= (unsigned)WIN ? e : 0.f; lsum[qt] += p[T][i]; }
                u32x4 w; w.x = pk2(p[0][0], p[0][1]); w.y = pk2(p[0][2], p[0][3]); w.z = pk2(p[1][0], p[1][1]); w.w = pk2(p[1][2], p[1][3]);
                const bf16x8 pf = __builtin_bit_cast(bf16x8, w);
#pragma unroll
                for (int dt = 0; dt < 4; ++dt) O[qt][dt] = __builtin_amdgcn_mfma_f32_16x16x32_bf16(vfr[dt], pf, O[qt][dt], 0, 0, 0);
            }
        }
    }
#pragma unroll
    for (int qt = 0; qt < 4; ++qt) mref[qt] -= slope * (float)base;
#pragma unroll
    for (int qt = 0; qt < 4; ++qt) {
        float ls = lsum[qt]; ls += __shfl_xor(ls, 16); ls += __shfl_xor(ls, 32);
        const float inv = 1.f / (ls + __builtin_amdgcn_exp2f(sinkl - mref[qt]));
        bf16_t* op = (bf16_t*)(a.ws + WS_B) + (qrow0 + qt * 16 + r) * 512 + h * 64 + 4 * qd;
#pragma unroll
        for (int dt = 0; dt < 4; ++dt) { u32x2 w; w.x = pk2(O[qt][dt][0] * inv, O[qt][dt][1] * inv); w.y = pk2(O[qt][dt][2] * inv, O[qt][dt][3] * inv); *(u32x2*)(op + dt * 16) = w; }
    }
    __syncthreads();
}
__device__ __forceinline__ void attn_sample_unit(const Args& a, LAS unsigned char* lds, int l, int b, int kvh, int tid) {
    constexpr int KST = 72, VST = 176, NKP = 160;
    LAS bf16_t* Ks = (LAS bf16_t*)lds; LAS bf16_t* Vt = Ks + NKP * KST;
    const bf16_t* Z = (const bf16_t*)(a.ws + WS_C);
    const float* gk = a.in[I_KG] + l * 64; const float* gq = a.in[I_QG] + l * 64;
    const float* ck = a.in[I_CK] + ((size_t)l * DEC_B + b) * WIN * 128 + kvh * 64; const float* cv = a.in[I_CV] + ((size_t)l * DEC_B + b) * WIN * 128 + kvh * 64;
    float* ko = a.out + O_KS + ((size_t)l * DEC_B + b) * WIN * 128 + kvh * 64; float* vo = a.out + O_VS + ((size_t)l * DEC_B + b) * WIN * 128 + kvh * 64;
    const size_t zrow0 = (size_t)NTOK_P + b * DEC_T;
    const int lane = tid & 63, r = lane & 15, qd = lane >> 4, t = r >> 2, h = kvh * 4 + (r & 3);
    u32x4 qraw[2];
    { const bf16_t* zq = Z + (zrow0 + t) * INC + ZQ + h * 64 + 8 * qd; qraw[0] = *(const u32x4*)zq; qraw[1] = *(const u32x4*)(zq + 32); }
    {
        f32x4 kv[4], vv[4];
#pragma unroll
        for (int k = 0; k < 4; ++k) { const int idx = tid + 512 * k, row = idx >> 4, c4 = idx & 15; kv[k] = *(const f32x4*)(ck + (size_t)row * 128 + c4 * 4); vv[k] = *(const f32x4*)(cv + (size_t)row * 128 + c4 * 4); }
        for (int i = tid; i < (NKP - WIN - DEC_T) * 64; i += 512) { const int row = WIN + DEC_T + (i >> 6), d = i & 63; Ks[row * KST + d] = 0; Vt[d * VST + row] = 0; }
#pragma unroll
        for (int k = 0; k < 4; ++k) { const int idx = tid + 512 * k, row = idx >> 4, c4 = idx & 15;
            u32x2 w; w.x = pk2(kv[k][0], kv[k][1]); w.y = pk2(kv[k][2], kv[k][3]); *(LAS u32x2*)(Ks + row * KST + c4 * 4) = w;
#pragma unroll
            for (int i = 0; i < 4; ++i) Vt[(c4 * 4 + i) * VST + row] = f2bf(vv[k][i]);
            if (row >= DEC_T) { *(f32x4*)(ko + (size_t)(row - DEC_T) * 128 + c4 * 4) = kv[k]; *(f32x4*)(vo + (size_t)(row - DEC_T) * 128 + c4 * 4) = vv[k]; } }
        if (tid < 256) { const int t2 = tid >> 6, d = tid & 63; const bf16_t* zr = Z + (zrow0 + t2) * INC + kvh * 64 + d;
            const float kr = bf2f(zr[ZK]), vr = bf2f(zr[ZV]); const float sq = wave_sum(kr * kr); const float kn = kr * rsqrtf(sq * (1.f / 64.f) + EPS) * gk[d];
            Ks[(WIN + t2) * KST + d] = f2bf(kn); Vt[d * VST + WIN + t2] = zr[ZV]; ko[(size_t)(WIN - DEC_T + t2) * 128 + d] = kn; vo[(size_t)(WIN - DEC_T + t2) * 128 + d] = vr; }
    }
    __syncthreads();
    if (tid < 64) {
        const float cs = 0.125f * LOG2E, sinkl = a.in[I_SINK][l * 8 + h] * LOG2E, slope = exp2f(-(float)(h + 1)) * LOG2E;
        bf16x8 qf[2];
        {   float x[16]; { float t8[8]; unpack8(qraw[0], t8);
#pragma unroll
                for (int k = 0; k < 8; ++k) x[k] = t8[k];
                unpack8(qraw[1], t8);
#pragma unroll
                for (int k = 0; k < 8; ++k) x[8 + k] = t8[k]; }
            float sq = 0.f;
#pragma unroll
            for (int k = 0; k < 16; ++k) sq += x[k] * x[k];
            sq += __shfl_xor(sq, 16); sq += __shfl_xor(sq, 32);
            const float rs = rsqrtf(sq * (1.f / 64.f) + EPS) * cs;
#pragma unroll
            for (int k = 0; k < 16; ++k) x[k] = x[k] * rs * gq[(k >> 3) * 32 + 8 * qd + (k & 7)];
#pragma unroll
            for (int s = 0; s < 2; ++s) { u32x4 w; w.x = pk2(x[8 * s], x[8 * s + 1]); w.y = pk2(x[8 * s + 2], x[8 * s + 3]); w.z = pk2(x[8 * s + 4], x[8 * s + 5]); w.w = pk2(x[8 * s + 6], x[8 * s + 7]);
                qf[s] = __builtin_bit_cast(bf16x8, w); } }
        f32x4 S[NKP / 16]; float mx = -1e30f;
#pragma unroll
        for (int T = 0; T < NKP / 16; ++T) {
            const bf16x8 k0 = *(const LAS bf16x8*)(Ks + (16 * T + r) * KST + 8 * qd), k1 = *(const LAS bf16x8*)(Ks + (16 * T + r) * KST + 32 + 8 * qd);
            S[T] = __builtin_amdgcn_mfma_f32_16x16x32_bf16(k0, qf[0], (f32x4){0.f, 0.f, 0.f, 0.f}, 0, 0, 0); S[T] = __builtin_amdgcn_mfma_f32_16x16x32_bf16(k1, qf[1], S[T], 0, 0, 0); }
#pragma unroll
        for (int T = 0; T < NKP / 16; ++T)
#pragma unroll
            for (int i = 0; i < 4; ++i) { const int dist = WIN + t - (16 * T + 4 * qd + i);
                const float s = (unsigned)dist <= (unsigned)WIN ? S[T][i] - slope * (float)dist : -1e30f; S[T][i] = s; mx = fmaxf(mx, s); }
        mx = fmaxf(mx, __shfl_xor(mx, 16)); mx = fmaxf(mx, __shfl_xor(mx, 32)); mx = fmaxf(mx, sinkl);
        float lsum = 0.f;
#pragma unroll
        for (int T = 0; T < NKP / 16; ++T)
#pragma unroll
            for (int i = 0; i < 4; ++i) { const float p = S[T][i] > -1e29f ? __builtin_amdgcn_exp2f(S[T][i] - mx) : 0.f; S[T][i] = p; lsum += p; }
        f32x4 O[4];
#pragma unroll
        for (int dt = 0; dt < 4; ++dt) O[dt] = (f32x4){0.f, 0.f, 0.f, 0.f};
#pragma unroll
        for (int st = 0; st < NKP / 32; ++st) {
            u32x4 w; w.x = pk2(S[2 * st][0], S[2 * st][1]); w.y = pk2(S[2 * st][2], S[2 * st][3]); w.z = pk2(S[2 * st + 1][0], S[2 * st + 1][1]); w.w = pk2(S[2 * st + 1][2], S[2 * st + 1][3]);
            const bf16x8 pf = __builtin_bit_cast(bf16x8, w);
#pragma unroll
            for (int dt = 0; dt < 4; ++dt) { const u32x2 lo = *(const LAS u32x2*)(Vt + (dt * 16 + r) * VST + 32 * st + 4 * qd), hi = *(const LAS u32x2*)(Vt + (dt * 16 + r) * VST + 32 * st + 16 + 4 * qd);
                O[dt] = __builtin_amdgcn_mfma_f32_16x16x32_bf16(__builtin_bit_cast(bf16x8, (u32x4){lo.x, lo.y, hi.x, hi.y}), pf, O[dt], 0, 0, 0); }
        }
        lsum += __shfl_xor(lsum, 16); lsum += __shfl_xor(lsum, 32);
        const float inv = __builtin_amdgcn_rcpf(lsum + __builtin_amdgcn_exp2f(sinkl - mx));
        bf16_t* op = (bf16_t*)(a.ws + WS_B) + (zrow0 + t) * 512 + h * 64 + 4 * qd;
#pragma unroll
        for (int dt = 0; dt < 4; ++dt) { u32x2 w; w.x = pk2(O[dt][0] * inv, O[dt][1] * inv); w.y = pk2(O[dt][2] * inv, O[dt][3] * inv); *(u32x2*)(op + dt * 16) = w; }
    }
    __syncthreads();
}

struct SsmTab { f32x4 ta; bf16x8 af[8]; bf16x8 cf[4]; float dsk; };
template <bool PASS_B> __device__ __forceinline__ void ssm_tables(const Args& a, int l, int gq, int wave, SsmTab& T) {
    const int lane = opq(threadIdx.x) & 63, r = lane & 15, qd = lane >> 4, g = gq * 8 + wave;
    T.ta = ((const f32x4*)(a.ws + WS_TA))[(l * NG + g) * NP + lane];
    const bf16_t* tbh = (const bf16_t*)(a.ws + WS_TB) + (size_t)(l * NG + g) * 128 * GC + r * GC + 8 * (qd & 1);
#pragma unroll
    for (int pt = 0; pt < 8; ++pt) { const bf16x8 v = *(const bf16x8*)(tbh + pt * 16 * GC); T.af[pt] = qd < 2 ? v : (bf16x8){0, 0, 0, 0, 0, 0, 0, 0}; }
    T.dsk = 0.f;
    if (PASS_B) { const bf16_t* tc = (const bf16_t*)(a.ws + WS_TC) + (size_t)(l * NG + g) * GC * 128 + r * 128 + qd * 8;
#pragma unroll
        for (int s = 0; s < 4; ++s) T.cf[s] = *(const bf16x8*)(tc + s * 32);
        T.dsk = a.in[I_DSK][l * 512 + g * 16 + r]; }
}
__device__ __forceinline__ void ssm_stage_load(const Args& a, size_t row0, int ntok, int gq, u32x4 (&pre)[2]) {
    const int tid = opq(threadIdx.x); const bf16_t* Z = (const bf16_t*)(a.ws + WS_C);
#pragma unroll
    for (int k = 0; k < 2; ++k) { const int idx = tid + 512 * k, t = idx >> 4, c8 = idx & 15; if (idx < ntok * 16) pre[k] = *(const u32x4*)(Z + (row0 + t) * INC + ZU + gq * 128 + c8 * 8); }
}
template <bool PASS_B> __device__ __forceinline__ void ssm_unit(const Args& a, LAS unsigned char* lds, const SsmTab& T, const u32x4 (&pre)[2], int l, size_t row0, int ntok, int gq, float& hr_io, float& hi_io, int wave) {
    const int tid = opq(threadIdx.x), lane = tid & 63, r = lane & 15, qd = lane >> 4;
    constexpr int UST = 136, XST = 132, HST = 136;
    LAS bf16_t* Ub = (LAS bf16_t*)lds;
    LAS float* Xs = (LAS float*)(lds + 64 * UST * 2) + wave * (16 * XST);
    LAS bf16_t* hb = (LAS bf16_t*)(lds + 64 * UST * 2 + 8 * 16 * XST * 4) + wave * (16 * HST);
    const int g = gq * 8 + wave;
    const f32x4 ta = T.ta; const float ar = ta[0], ai = ta[1], dsk = T.dsk;
    float hr = hr_io, hi = hi_io;
#pragma unroll
    for (int k = 0; k < 2; ++k) { const int idx = tid + 512 * k, t = idx >> 4, c8 = idx & 15; if (idx < ntok * 16) *(LAS u32x4*)(Ub + t * UST + c8 * 8) = pre[k]; }
    __syncthreads();
#pragma unroll 1
    for (int t0 = 0; t0 < ntok; t0 += 16) {
        const int nt = (ntok - t0) < 16 ? (ntok - t0) : 16;
        {
            const bf16x8 uv = *(const LAS bf16x8*)(Ub + (t0 + r) * UST + wave * 16 + 8 * (qd & 1)); const bf16x8 ub = qd < 2 ? uv : (bf16x8){0, 0, 0, 0, 0, 0, 0, 0};
#pragma unroll
            for (int pt = 0; pt < 8; ++pt) { const f32x4 x = __builtin_amdgcn_mfma_f32_16x16x32_bf16(T.af[pt], ub, (f32x4){0.f, 0.f, 0.f, 0.f}, 0, 0, 0); *(LAS f32x4*)(Xs + r * XST + pt * 16 + 4 * qd) = x; }
        }
        asm volatile("" ::: "memory");
        {
            typedef float f32x2 __attribute__((ext_vector_type(2)));
            f32x2 xv[16];
#pragma unroll
            for (int tt = 0; tt < 16; ++tt) xv[tt] = *(const LAS f32x2*)(Xs + tt * XST + 2 * lane);
            f32x2 h = {hr, hi}; const f32x2 a1 = {ar, ar}, a2 = {-ai, ai};
            if (nt == 16) {
#pragma unroll
                for (int tt = 0; tt < 16; ++tt) { const f32x2 hs = {h.y, h.x}; h = a1 * h + (a2 * hs + xv[tt]);
                    if (PASS_B) *(LAS unsigned*)(hb + tt * HST + 2 * lane) = pk2(h.x, h.y); }
            } else {
#pragma unroll
                for (int tt = 0; tt < 16; ++tt) if (tt < nt) { const f32x2 hs = {h.y, h.x}; h = a1 * h + (a2 * hs + xv[tt]);
                    if (PASS_B) *(LAS unsigned*)(hb + tt * HST + 2 * lane) = pk2(h.x, h.y); }
            }
            hr = h.x; hi = h.y;
        }
        if (PASS_B) {
            f32x4 acc = {0.f, 0.f, 0.f, 0.f};
            asm volatile("" ::: "memory");
#pragma unroll
            for (int s = 0; s < 4; ++s) { const bf16x8 hf = *(const LAS bf16x8*)(hb + r * HST + s * 32 + qd * 8); acc = __builtin_amdgcn_mfma_f32_16x16x32_bf16(hf, T.cf[s], acc, 0, 0, 0); }
            asm volatile("" ::: "memory");
            bf16_t* yo = (bf16_t*)(a.ws + WS_B + HALFROWS);
#pragma unroll
            for (int k = 0; k < 4; ++k) { const int tt = 4 * qd + k;
                if (tt < nt) { const float y = acc[k] + dsk * bf2f(Ub[(t0 + tt) * UST + wave * 16 + r]); yo[(row0 + t0 + tt) * 512 + g * 16 + r] = f2bf(gelu_tanh(y)); } }
        }
        asm volatile("" ::: "memory");
    }
    hr_io = hr; hi_io = hi;
    __syncthreads();
}

#define XB_TMO      128
#define XB_XCNT(j)  (256  + 64 * (j))
#define XB_XSUB(j)  (1280 + 64 * (j))
#define XB_XGEN(j)  (2304 + 64 * (j))
#define XB_TOP      3328
#define XB_TOPGEN   3392
#define XCD_BAR_WORDS 3456
#define XB_SPIN_CAP (1u << 18)

__device__ __forceinline__ unsigned xb_ld(unsigned* p)              { return __hip_atomic_load(p, __ATOMIC_RELAXED, __HIP_MEMORY_SCOPE_AGENT); }
__device__ __forceinline__ unsigned xb_add(unsigned* p, unsigned v) { return __hip_atomic_fetch_add(p, v, __ATOMIC_RELAXED, __HIP_MEMORY_SCOPE_AGENT); }
__device__ __forceinline__ unsigned xb_xcc_id() { return (unsigned)__builtin_amdgcn_s_getreg((3 << 11) | 20) & 0xFu; }
#define XB_SPIN(cond, bar) do { unsigned _sp = 0; while (cond) { __builtin_amdgcn_s_sleep(1); \
    if ((++_sp & 255u) == 0u) { if (xb_ld(&(bar)[XB_TMO])) break; if (_sp > XB_SPIN_CAP) { atomicAdd(&(bar)[XB_TMO], 1u); break; } } } } while (0)

struct XcdBarrier {
    unsigned* bar; unsigned x;
    volatile LAS unsigned* st;
};

__device__ __forceinline__ XcdBarrier xcd_barrier_post(unsigned* bar, volatile LAS unsigned* st) {
    XcdBarrier b; b.bar = bar; b.x = xb_xcc_id(); b.st = st;
    if (threadIdx.x == 0) (void)xb_add(&bar[XB_XCNT(b.x)], 1u);
    return b;
}
__device__ __forceinline__ void xcd_barrier_complete(unsigned* bar, unsigned x, unsigned& nloc, unsigned& nx) {
    const unsigned G = gridDim.x * gridDim.y * gridDim.z;
    unsigned sum, cnt, mine, sp = 0u;
    for (;;) {
        sum = 0u; cnt = 0u; mine = 0u;
#pragma unroll
        for (unsigned j = 0; j < 16; ++j) { const unsigned c = xb_ld(&bar[XB_XCNT(j)]); sum += c; cnt += (c > 0u) ? 1u : 0u; mine = (j == x) ? c : mine; }
        if (sum == G) break;
        __builtin_amdgcn_s_sleep(1);
        if ((++sp & 255u) == 0u) { if (xb_ld(&bar[XB_TMO])) break; if (sp > XB_SPIN_CAP) { atomicAdd(&bar[XB_TMO], 1u); break; } }
    }
    nloc = mine > 0u ? mine : 1u; nx = cnt > 0u ? cnt : 1u;
}

__device__ __forceinline__ void xcd_barrier(const XcdBarrier& b) {
    asm volatile("s_waitcnt vmcnt(0)" ::: "memory");
    __syncthreads();
    if (threadIdx.x == 0) {
        unsigned* bar = b.bar;
        __builtin_amdgcn_s_waitcnt(0);
        unsigned nloc = b.st[0], nx = b.st[1];
        if (nloc == 0u) { xcd_barrier_complete(bar, b.x, nloc, nx); b.st[0] = nloc; b.st[1] = nx; }
        const unsigned old = xb_add(&bar[XB_XSUB(b.x)], 1u);
        const unsigned gen = old / nloc;
        if (old + 1u == (gen + 1u) * nloc) {
            __builtin_amdgcn_fence(__ATOMIC_RELEASE, "agent");
            asm volatile("s_waitcnt vmcnt(0)" ::: "memory");
            const unsigned og = xb_add(&bar[XB_TOP], 1u);
            const unsigned tg = og / nx;
            if (og + 1u == (tg + 1u) * nx) xb_add(&bar[XB_TOPGEN], 1u);
            else XB_SPIN(xb_ld(&bar[XB_TOPGEN]) == tg, bar);
            __builtin_amdgcn_fence(__ATOMIC_ACQUIRE, "agent");
            xb_add(&bar[XB_XGEN(b.x)], 1u);
            asm volatile("s_waitcnt vmcnt(0)" ::: "memory");
        } else {
            XB_SPIN(xb_ld(&bar[XB_XGEN(b.x)]) == gen, bar);
            __builtin_amdgcn_fence(__ATOMIC_ACQUIRE, "agent");
            asm volatile("s_waitcnt vmcnt(0)" ::: "memory");
        }
    }
    __syncthreads();
}

__global__ void __launch_bounds__(512, 2) mk_fwd(Args a) {
    extern __shared__ __attribute__((aligned(16))) unsigned char lds_raw[];
    LAS unsigned char* lds = (LAS unsigned char*)lds_raw;
    cg::grid_group grid = cg::this_grid();
    const int tid = threadIdx.x, lane = tid & 63, wave = __builtin_amdgcn_readfirstlane(tid >> 6);
    const int G = gridDim.x, bx = blockIdx.x;
    unsigned char* ws = a.ws;
    float* ss = (float*)(ws + WS_SS);
    bf16_t* bufA = (bf16_t*)(ws + WS_A);
    bf16_t* mixed = (bf16_t*)a.out;
    bf16_t* attn = (bf16_t*)(ws + WS_B); bf16_t* ssmy = (bf16_t*)(ws + WS_B + HALFROWS); bf16_t* xb2 = (bf16_t*)(ws + WS_B);
    bf16_t* Z = (bf16_t*)(ws + WS_C); bf16_t* ssmg = (bf16_t*)(ws + WS_C + ZBYTES); float* Ebuf = (float*)(ws + WS_C + ZBYTES + HALFROWS); bf16_t* H = (bf16_t*)(ws + WS_C);

    unsigned* barw = (unsigned*)(ws + 16384);
    volatile LAS unsigned* bst = (volatile LAS unsigned*)(lds + LDS_BYTES - 64);
    if (bx == 0) for (int i = tid; i < XCD_BAR_WORDS; i += 512) barw[i] = 0u;
    if (tid < 2) bst[tid] = 0u;
    __syncthreads();
    grid.sync();
    { const int t2 = opq(threadIdx.x); prologue(a, lds, t2, wave, t2 & 63); }
    (void)xcd_barrier_post(barw, bst);
#define GRID_BAR() do { XcdBarrier b_; b_.bar = (unsigned*)(a.ws + 16384); b_.x = xb_xcc_id(); b_.st = (volatile LAS unsigned*)(lds + LDS_BYTES - 64); xcd_barrier(b_); } while (0)
    GRID_BAR();
#pragma unroll 1
    for (int l = 0; l < 2; ++l) {
        const bf16_t* Wl = (const bf16_t*)(ws + WS_W) + (size_t)l * W_LAYER;
        float* ss1 = ss + (size_t)(2 * l) * MTOK; float* ss2 = ss + (size_t)(2 * l + 1) * MTOK; float* ss1n = ss + (size_t)(2 * l + 2) * MTOK;
        { pg8::Gemm g{bufA, Wl + W_IN, NTOK_P, INC - 256, DM}; pg8::StaticOrder S; S.init(NTOK_P, INC - 256, G, bx); EpiIn E{Z, ss1, a.in[I_BG] + l * 2048, 0};
          pg8::gemm_phase<EpiIn, pg8::StaticOrder, true, true>(lds, g, S, E);
          skinny_gemm<4>(lds, bufA, Wl + W_IN, INC, DM, E, 0); }
        GRID_BAR();
#ifndef REP_MIX
#define REP_MIX 1
#endif
#pragma unroll 1
        for (int rep = 0; rep < REP_MIX; ++rep) {
#ifndef SKIP_AP
        for (int u = bx; u < 256; u += G) attn_prompt_unit(a, lds, l, u >> 5, (u >> 1) & 15, u & 1, opq(threadIdx.x));
#endif
#ifndef SKIP_AS
        for (int u = bx; u < 2 * DEC_B; u += G) attn_sample_unit(a, lds, l, u >> 1, u & 1, opq(threadIdx.x));
#endif
#ifndef SKIP_SA
        {   SsmTab T; ssm_tables<false>(a, l, bx & 3, wave, T); u32x4 pre[2];
            for (int u = bx; u < NBATCH * (NSEG - 1) * 4; u += G) { const int gq = u & 3, seg = (u >> 2) % (NSEG - 1), b = (u >> 2) / (NSEG - 1);
                const size_t r0 = (size_t)b * SEQ + (size_t)seg * (SEGB * SBLK); float hr = 0.f, hi = 0.f;
                ssm_stage_load(a, r0, SBLK, gq, pre);
#pragma unroll 1
                for (int blk = 0; blk < SEGB; ++blk) { u32x4 cur[2] = {pre[0], pre[1]};
                    if (blk + 1 < SEGB) ssm_stage_load(a, r0 + (blk + 1) * SBLK, SBLK, gq, pre);
                    ssm_unit<false>(a, lds, T, cur, l, r0 + blk * SBLK, SBLK, gq, hr, hi, wave); }
                const int lane = opq(threadIdx.x) & 63, g = gq * 8 + wave;
                *(float2*)(Ebuf + ((((size_t)b * NSEG + seg) * NG + g) * NP + lane) * 2) = make_float2(hr, hi); } }
#endif
        GRID_BAR();
        {   SsmTab T; ssm_tables<true>(a, l, bx & 3, wave, T); u32x4 pre[2];
            for (int u = bx; u < NBATCH * NSEG * 4; u += G) { const int gq = u & 3, seg = (u >> 2) % NSEG, b = (u >> 2) / NSEG;
                const size_t r0 = (size_t)b * SEQ + (size_t)seg * (SEGB * SBLK); const int lane = opq(threadIdx.x) & 63, g = gq * 8 + wave;
                ssm_stage_load(a, r0, SBLK, gq, pre);
                float hr = 0.f, hi = 0.f;
                {
                    float2 e[NSEG - 1];
#pragma unroll
                    for (int i = 0; i < NSEG - 1; ++i) e[i] = (i < seg) ? *(const float2*)(Ebuf + ((((size_t)b * NSEG + i) * NG + g) * NP + lane) * 2) : make_float2(0.f, 0.f);
#pragma unroll
                    for (int i = 0; i < NSEG - 1; ++i) if (i < seg) { const float nr = T.ta[2] * hr - T.ta[3] * hi + e[i].x, ni = T.ta[2] * hi + T.ta[3] * hr + e[i].y; hr = nr; hi = ni; } }
#pragma unroll 1
                for (int blk = 0; blk < SEGB; ++blk) { u32x4 cur[2] = {pre[0], pre[1]};
                    if (blk + 1 < SEGB) ssm_stage_load(a, r0 + (blk + 1) * SBLK, SBLK, gq, pre);
                    ssm_unit<true>(a, lds, T, cur, l, r0 + blk * SBLK, SBLK, gq, hr, hi, wave); }
                if (seg == NSEG - 1) { const size_t so = ((size_t)l * NBATCH + b) * NG * NP + g * NP + lane; a.out[O_HRP + so] = hr; a.out[O_HIP + so] = hi; } }
            for (int v = bx; v < DEC_B * 4; v += G) { const int gq = v & 3, b = v >> 2; const int lane = opq(threadIdx.x) & 63, g = gq * 8 + wave;
                const size_t so = ((size_t)l * DEC_B + b) * NG * NP + g * NP + lane;
                ssm_stage_load(a, (size_t)NTOK_P + b * DEC_T, DEC_T, gq, pre);
                float hr = a.in[I_SR][so], hi = a.in[I_SI][so];
                ssm_unit<true>(a, lds, T, pre, l, (size_t)NTOK_P + b * DEC_T, DEC_T, gq, hr, hi, wave);
                a.out[O_HRS + so] = hr; a.out[O_HIS + so] = hi; } }
        GRID_BAR();
        }
        { pg8::Gemm g{ssmy, Wl + W_GLU, NTOK_P, 512, 512}; pg8::StaticOrder S; S.init(NTOK_P, 512, G, bx); EpiGlu E{ssmy, ssmg, a.in[I_BGLU] + l * 512};
          pg8::gemm_phase<EpiGlu, pg8::StaticOrder, true, true>(lds, g, S, E);
          { pg8::Gemm g1{bufA, Wl + W_IN + (size_t)(INC - 256) * DM, NTOK_P, 256, DM}; pg8::StaticOrder S1; S1.init(NTOK_P, 256, G, (bx + G - 128) % G); EpiIn E1{Z, ss1, a.in[I_BG] + l * 2048, INC / 256 - 1};
            pg8::gemm_phase<EpiIn, pg8::StaticOrder, true, true>(lds, g1, S1, E1); }
          skinny_gemm<2>(lds, ssmy, Wl + W_GLU, 512, 512, E, 192); }
        GRID_BAR();
        { pg8::Gemm g{attn, Wl + W_AO, NTOK_P, DM, 512}; pg8::StaticOrder S; S.init(NTOK_P, DM, G, bx); EpiMix<false> E{Z + ZG, mixed};
          pg8::gemm_phase<EpiMix<false>, pg8::StaticOrder, true, true>(lds, g, S, E);
          skinny_gemm<2>(lds, attn, Wl + W_AO, DM, 512, E, 0); }
        { pg8::Gemm g{ssmg, Wl + W_SO, NTOK_P, DM, 512}; pg8::StaticOrder S; S.init(NTOK_P, DM, G, bx); EpiMix<true> E{Z + ZG + DM, mixed};
          pg8::gemm_phase<EpiMix<true>, pg8::StaticOrder, true, true>(lds, g, S, E);
          skinny_gemm<2>(lds, ssmg, Wl + W_SO, DM, 512, E, 0); }
        GRID_BAR();
        { pg8::Gemm g{mixed, Wl + W_OUT, NTOK_P, DM, DM}; pg8::StaticOrder S; S.init(NTOK_P, DM, G, bx);
          EpiRes E{bufA, xb2, nullptr, ss2};
          pg8::gemm_phase<EpiRes, pg8::StaticOrder, true, true>(lds, g, S, E);
          skinny_gemm<2>(lds, mixed, Wl + W_OUT, DM, DM, E, 0); }
        GRID_BAR();
        { pg8::Gemm g{xb2, Wl + W_UP, NTOK_P, FF, DM}; pg8::StaticOrder S; S.init(NTOK_P, FF, G, bx); EpiUp E{H, ss2};
          pg8::gemm_phase<EpiUp, pg8::StaticOrder, true, true>(lds, g, S, E);
          skinny_gemm<4>(lds, xb2, Wl + W_UP, FF, DM, E, 0); }
        GRID_BAR();
        { pg8::Gemm g{H, Wl + W_DN, NTOK_P, DM, FF}; pg8::StaticOrder S; S.init(NTOK_P, DM, G, bx);
          EpiRes E{xb2, l == 0 ? bufA : nullptr, l == 0 ? nullptr : a.out, l == 0 ? ss1n : nullptr};
          pg8::gemm_phase<EpiRes, pg8::StaticOrder, true, true>(lds, g, S, E);
          skinny_gemm<2>(lds, H, Wl + W_DN, DM, FF, E, 0); }
        if (l == 0) GRID_BAR();
    }
}

extern "C" void kernel_launch(void* const* d_in, const int* in_sizes, int n_in, void* d_out, int out_size, void* d_ws, size_t ws_size, hipStream_t stream) {
    static int grid = 0;
    if (grid == 0) {
        if (n_in != 28 || (size_t)out_size != O_END || ws_size < WS_END) { fprintf(stderr, "kernel_launch: unexpected shapes n_in %d out %d ws %zu\n", n_in, out_size, ws_size); grid = -1; return; }
        int dev = 0, cus = 0, per_cu = 0;
        (void)hipGetDevice(&dev);
        (void)hipDeviceGetAttribute(&cus, hipDeviceAttributeMultiprocessorCount, dev);
        (void)hipFuncSetAttribute((const void*)mk_fwd, hipFuncAttributeMaxDynamicSharedMemorySize, LDS_BYTES);
        (void)hipOccupancyMaxActiveBlocksPerMultiprocessor(&per_cu, (const void*)mk_fwd, 512, LDS_BYTES);
        if (per_cu < 1) { fprintf(stderr, "kernel_launch: occupancy query reports %d blocks per CU\n", per_cu); grid = -1; return; }
        grid = cus & ~3;
    }
    if (grid < 0) return;
    Args a{};
    for (int i = 0; i < 28; ++i) a.in[i] = (const float*)d_in[i];
    a.out = (float*)d_out; a.ws = (unsigned char*)d_ws;
    void* args[] = {&a};
    hipError_t e = hipLaunchCooperativeKernel((const void*)mk_fwd, dim3(grid), dim3(512), args, LDS_BYTES, stream);
    if (e != hipSuccess) fprintf(stderr, "cooperative launch failed: %s (grid %d)\n", hipGetErrorString(e), grid);
}
```

```cpp
#include <hip/hip_runtime.h>
#include <hip/hip_cooperative_groups.h>
#include <cstdio>
#include <cstdint>
namespace cg = cooperative_groups;
namespace pg8 {
#define PG8_LAS __attribute__((address_space(3)))
typedef unsigned short bf16_t;
typedef short bf16x8 __attribute__((ext_vector_type(8)));
typedef float f32x4 __attribute__((ext_vector_type(4)));
typedef unsigned u32x4 __attribute__((ext_vector_type(4)));
constexpr int BM = 256, BK = 64, HALF = 128, HTB = HALF * BK * 2  , STAGE_BYTES = 8 * HTB, NXCD = 8, WGM = 8;

__host__ __device__ __forceinline__ int lds_byte(int r, int c) { const int st = (r >> 4) * 2 + (c >> 5), rr = r & 15, cc = c & 31, ob = rr * 64 + cc * 2; return st * 1024 + (ob ^ (((ob >> 9) & 1) << 5)); }
__host__ __device__ __forceinline__ void stage_rc(int b, int& R, int& C) { const int st = b / 1024, sb = b % 1024, swz = sb ^ (((sb >> 9) & 1) << 5); R = (st >> 1) * 16 + swz / 64; C = (st & 1) * 32 + (swz % 64) / 2; }
__host__ __device__ __forceinline__ int perm32(int rho) { const int n = rho >> 4, i = rho & 15; return 8 * (i >> 2) + 4 * n + (i & 3); }

struct Unit { int pm, pn, slot; };
struct Gemm { const bf16_t* A; const bf16_t* Bt; int M, N, K; };

struct StaticOrder {
    int nM, nN, nwg, G, c;
    __host__ __device__ void init(int M, int N, int G_, int c_) { nM = M / BM; nN = N / BM; nwg = nM * nN; G = G_; c = c_; }
    __host__ __device__ bool next(int i, Unit& u) const {
        const long L = (long)i * G + c; if (L >= nwg) return false;
        int wgid = (int)L; { const int q = nwg / NXCD, r = nwg % NXCD, xcd = wgid % NXCD, off = wgid / NXCD; wgid = (xcd < r ? xcd * (q + 1) : r * (q + 1) + (xcd - r) * q) + off; }
        const int nig = WGM * nN, gid = wgid / nig, fm = gid * WGM, gsz = (nM - fm) < WGM ? (nM - fm) : WGM;
        u.pm = fm + ((wgid % nig) % gsz); u.pn = (wgid % nig) / gsz; return true;
    }
    __device__ __forceinline__ void a_ready(const Unit&) const {}
    __device__ __forceinline__ void done(const Unit&) const {}
};
__device__ __forceinline__ unsigned cvt_pk_bf16(float lo, float hi) { unsigned r; asm volatile("v_cvt_pk_bf16_f32 %0, %1, %2" : "=v"(r) : "v"(lo), "v"(hi)); return r; }
typedef float f32x2 __attribute__((ext_vector_type(2)));
template <class Epi, class Sched, bool ALIGN_EPI = false, bool SP2 = false>
__device__ __forceinline__ void gemm_phase(PG8_LAS unsigned char* lds, const Gemm g, const Sched& S, const Epi& E) {
    int tid_ = threadIdx.x; asm volatile("" : "+v"(tid_));
    const int tid = tid_, wid = __builtin_amdgcn_readfirstlane(tid >> 6), lane = tid & 63, wr = wid >> 2, wc = wid & 3, fr = lane & 15, fq = lane >> 4;
    const int K = g.K, nt = K / BK;
    unsigned voffA[2], voffB[2];
#pragma unroll
    for (int i = 0; i < 2; ++i) { int R, C; stage_rc(tid * 16 + i * 8192, R, C); const int Rb = Epi::PERM ? ((R & ~31) + perm32(R & 31)) : R;
        voffA[i] = (unsigned)(R * K + C) * 2u; voffB[i] = (unsigned)(Rb * K + C) * 2u; }
    const size_t kstep = (size_t)(BK * 2);
    const size_t hstep = (size_t)HALF * K * 2;
    const size_t tstep = 2 * hstep;
    const unsigned ldsw = (unsigned)wid * 1024u;
    const int aoff = lds_byte(wr * 64 + fr, fq * 8), boff = lds_byte(wc * 32 + fr, fq * 8);
#define PG8_SA(b, h) (((b) * 2 + (h)) * HTB)
#define PG8_SB(b, h) ((4 + (b) * 2 + (h)) * HTB)
#define PG8_STAGE(bufoff, gbase, voff) do { _Pragma("unroll") for (int _i = 0; _i < 2; ++_i) \
        __builtin_amdgcn_global_load_lds((const unsigned*)((const char*)(gbase) + (voff)[_i]), (PG8_LAS unsigned*)(lds + (bufoff) + ldsw + _i * 8192), 16, 0, 0); } while (0)
#define PG8_LDA(dst, b, h) do { _Pragma("unroll") for (int m = 0; m < 4; ++m) _Pragma("unroll") for (int k = 0; k < 2; ++k) dst[m][k] = *(const PG8_LAS bf16x8*)(lds + PG8_SA(b, h) + aoff + m * 2048 + k * 1024); } while (0)
#define PG8_LDB(dst, b, h) do { _Pragma("unroll") for (int n = 0; n < 2; ++n) _Pragma("unroll") for (int k = 0; k < 2; ++k) dst[n][k] = *(const PG8_LAS bf16x8*)(lds + PG8_SB(b, h) + boff + n * 2048 + k * 1024); } while (0)
#define PG8_MMA(ai, bj, At, Bt) do { __builtin_amdgcn_s_setprio(1); _Pragma("unroll") for (int m = 0; m < 4; ++m) _Pragma("unroll") for (int n = 0; n < 2; ++n) _Pragma("unroll") for (int k = 0; k < 2; ++k) \
        acc[ai][bj][m][n] = __builtin_amdgcn_mfma_f32_16x16x32_bf16(Bt[n][k], At[m][k], acc[ai][bj][m][n], 0, 0, 0); __builtin_amdgcn_s_setprio(0); } while (0)
#define PG8_WAIT_V(n) asm volatile("s_waitcnt vmcnt(" #n ")" ::: "memory")
#define PG8_WAIT_L(n) asm volatile("s_waitcnt lgkmcnt(" #n ")" ::: "memory")
#define PG8_BAR __builtin_amdgcn_s_barrier()
#define PG8_SCHED __builtin_amdgcn_sched_barrier(0)
    Unit cur, nxt; int ui = 0;
    if (!S.next(0, cur)) return;
    f32x4 acc[2][2][4][2];
#pragma unroll
    for (int a = 0; a < 2; ++a)
#pragma unroll
        for (int b = 0; b < 2; ++b)
#pragma unroll
            for (int m = 0; m < 4; ++m)
#pragma unroll
                for (int n = 0; n < 2; ++n) acc[a][b][m][n] = (f32x4){0.f, 0.f, 0.f, 0.f};
    bf16x8 At[4][2], B0[2][2], B1[2][2];
    const char* cA = (const char*)g.A + (size_t)cur.pm * tstep; const char* cB = (const char*)g.Bt + (size_t)cur.pn * tstep;
    S.a_ready(cur);
    if constexpr (SP2) {
        PG8_STAGE(PG8_SB(0, 0), cB, voffB); PG8_STAGE(PG8_SB(0, 1), cB + hstep, voffB); PG8_STAGE(PG8_SA(0, 0), cA, voffA); PG8_STAGE(PG8_SA(0, 1), cA + hstep, voffA);
        if (wr == 1) PG8_BAR;
        PG8_WAIT_V(2); PG8_BAR;
        PG8_STAGE(PG8_SB(1, 0), cB + kstep, voffB); PG8_STAGE(PG8_SA(1, 0), cA + kstep, voffA); PG8_STAGE(PG8_SB(1, 1), cB + hstep + kstep, voffB);
        PG8_WAIT_V(6); PG8_BAR;
    } else {
        PG8_STAGE(PG8_SB(0, 0), cB, voffB); PG8_STAGE(PG8_SA(0, 0), cA, voffA); PG8_STAGE(PG8_SB(0, 1), cB + hstep, voffB); PG8_STAGE(PG8_SA(0, 1), cA + hstep, voffA);
        if (wr == 1) PG8_BAR;
        PG8_WAIT_V(4); PG8_BAR;
        PG8_STAGE(PG8_SB(1, 0), cB + kstep, voffB); PG8_STAGE(PG8_SA(1, 0), cA + kstep, voffA); PG8_STAGE(PG8_SB(1, 1), cB + hstep + kstep, voffB);
        PG8_WAIT_V(6); PG8_BAR;
    }
    for (;;) {
        const bool has_next = S.next(ui + 1, nxt);
        const char* nA = has_next ? (const char*)g.A + (size_t)nxt.pm * tstep : cA; const char* nB = has_next ? (const char*)g.Bt + (size_t)nxt.pn * tstep : cB;
        for (int t = 0; t < nt; t += 2) {
            const bool last = (t == nt - 2);
            const char* a1 = cA + (size_t)(t + 1) * kstep;
            const char* a2 = last ? nA : cA + (size_t)(t + 2) * kstep; const char* b2 = last ? nB : cB + (size_t)(t + 2) * kstep;
            const char* a3 = a2 + kstep; const char* b3 = b2 + kstep;
            if (last && has_next) S.a_ready(nxt);
            if constexpr (SP2) {
            PG8_LDB(B0, 0, 0); PG8_LDB(B1, 0, 1); PG8_SCHED; PG8_LDA(At, 0, 0); PG8_STAGE(PG8_SA(1, 1), a1 + hstep, voffA);
            PG8_WAIT_V(8); PG8_WAIT_L(0); PG8_BAR; PG8_MMA(0, 0, At, B0); PG8_MMA(0, 1, At, B1); PG8_BAR; PG8_SCHED;
            PG8_LDA(At, 0, 1); PG8_STAGE(PG8_SB(0, 0), b2, voffB); PG8_STAGE(PG8_SB(0, 1), b2 + hstep, voffB); PG8_STAGE(PG8_SA(0, 0), a2, voffA);
            PG8_WAIT_V(8); PG8_WAIT_L(0); PG8_BAR; PG8_MMA(1, 0, At, B0); PG8_MMA(1, 1, At, B1); PG8_BAR; PG8_SCHED;
            PG8_LDB(B0, 1, 0); PG8_LDB(B1, 1, 1); PG8_SCHED; PG8_LDA(At, 1, 0); PG8_STAGE(PG8_SA(0, 1), a2 + hstep, voffA);
            PG8_WAIT_V(8); PG8_WAIT_L(0); PG8_BAR; PG8_MMA(0, 0, At, B0); PG8_MMA(0, 1, At, B1); PG8_BAR; PG8_SCHED;
            PG8_LDA(At, 1, 1); PG8_STAGE(PG8_SB(1, 0), b3, voffB); PG8_STAGE(PG8_SB(1, 1), b3 + hstep, voffB); PG8_STAGE(PG8_SA(1, 0), a3, voffA);
            PG8_WAIT_V(8); PG8_WAIT_L(0); PG8_BAR; PG8_MMA(1, 0, At, B0); PG8_MMA(1, 1, At, B1); PG8_BAR; PG8_SCHED;
            } else {
            PG8_LDB(B0, 0, 0); PG8_SCHED; PG8_LDA(At, 0, 0); PG8_STAGE(PG8_SA(1, 1), a1 + hstep, voffA);
            PG8_WAIT_L(8); PG8_BAR; PG8_WAIT_L(0); PG8_MMA(0, 0, At, B0); PG8_BAR; PG8_SCHED;
            PG8_LDB(B1, 0, 1); PG8_STAGE(PG8_SB(0, 0), b2, voffB);
            PG8_BAR; PG8_WAIT_L(0); PG8_MMA(0, 1, At, B1); PG8_BAR;
            PG8_LDA(At, 0, 1); PG8_STAGE(PG8_SA(0, 0), a2, voffA);
            PG8_BAR; PG8_WAIT_L(0); PG8_MMA(1, 0, At, B0); PG8_BAR; PG8_SCHED;
            PG8_STAGE(PG8_SB(0, 1), b2 + hstep, voffB);
            PG8_WAIT_V(6); PG8_BAR; PG8_MMA(1, 1, At, B1); PG8_BAR;
            PG8_LDB(B0, 1, 0); PG8_SCHED; PG8_LDA(At, 1, 0); PG8_STAGE(PG8_SA(0, 1), a2 + hstep, voffA);
            PG8_WAIT_L(8); PG8_BAR; PG8_WAIT_L(0); PG8_MMA(0, 0, At, B0); PG8_BAR; PG8_SCHED;
            PG8_LDB(B1, 1, 1); PG8_STAGE(PG8_SB(1, 0), b3, voffB);
            PG8_BAR; PG8_WAIT_L(0); PG8_MMA(0, 1, At, B1); PG8_BAR;
            PG8_LDA(At, 1, 1); PG8_STAGE(PG8_SA(1, 0), a3, voffA);
            PG8_BAR; PG8_WAIT_L(0); PG8_MMA(1, 0, At, B0); PG8_BAR; PG8_SCHED;
            PG8_STAGE(PG8_SB(1, 1), b3 + hstep, voffB);
            PG8_WAIT_V(6); PG8_BAR; PG8_MMA(1, 1, At, B1); PG8_BAR;
            }
        }
        if constexpr (ALIGN_EPI) { if (wr == 0) PG8_BAR; }
        if constexpr (!Epi::AFTER_DRAIN) { E(acc, cur, wr, wc, fr, fq); S.done(cur); }
        if (!has_next) break;
#pragma unroll
        for (int a = 0; a < 2; ++a)
#pragma unroll
            for (int b = 0; b < 2; ++b)
#pragma unroll
                for (int m = 0; m < 4; ++m)
#pragma unroll
                    for (int n = 0; n < 2; ++n) acc[a][b][m][n] = (f32x4){0.f, 0.f, 0.f, 0.f};
        cur = nxt; cA = nA; cB = nB; ++ui;
        if constexpr (ALIGN_EPI) { if (wr == 1) PG8_BAR; }
    }
    PG8_WAIT_V(0);
    if constexpr (!ALIGN_EPI) { if (wr == 0) PG8_BAR; }
    PG8_BAR;
    if constexpr (Epi::AFTER_DRAIN) { E.fused(acc, cur, wr, wc, fr, fq, lds, wid, lane); S.done(cur); }
#undef PG8_SA
#undef PG8_SB
#undef PG8_STAGE
#undef PG8_LDA
#undef PG8_LDB
#undef PG8_MMA
#undef PG8_WAIT_V
#undef PG8_WAIT_L
#undef PG8_BAR
#undef PG8_SCHED
}
}
using pg8::bf16_t; using pg8::bf16x8; using pg8::f32x4; using pg8::u32x4; using pg8::Unit;
#define LAS __attribute__((address_space(3)))
typedef unsigned u32x2 __attribute__((ext_vector_type(2)));

constexpr int DM = 1024, SEQ = 2048, NBATCH = 8, DEC_B = 128, DEC_T = 4, WIN = 128;
constexpr int NTOK_P = NBATCH * SEQ, NTOK_S = DEC_B * DEC_T, MTOK = NTOK_P + NTOK_S;
constexpr int INC = 3328, FF = 4096, NG = 32, NP = 64, GC = 16;
constexpr int ZQ = 0, ZK = 512, ZV = 640, ZU = 768, ZG = 1280;
constexpr int SBLK = 64, SEGB = 4, NSEG = SEQ / (SBLK * SEGB);
constexpr float EPS = 1e-6f, LOG2E = 1.4426950408889634f;
constexpr size_t MiB = 1u << 20;
constexpr size_t WS_SS = 1 * MiB, WS_TA = 1 * MiB + 512 * 1024, WS_TC = 1 * MiB + 640 * 1024, WS_TB = 2 * MiB;
constexpr size_t WS_W = 3 * MiB, WS_A = 57 * MiB, WS_B = 90 * MiB, WS_C = 123 * MiB, WS_END = 255 * MiB;
constexpr size_t W_IN = 0, W_GLU = W_IN + (size_t)INC * DM, W_AO = W_GLU + 512 * 512, W_SO = W_AO + 1024 * 512, W_OUT = W_SO + 1024 * 512,
                 W_UP = W_OUT + 1024 * 1024, W_DN = W_UP + (size_t)FF * DM, W_LAYER = W_DN + (size_t)FF * DM;
static_assert(WS_W + 2 * W_LAYER * 2 <= WS_A, "weights fit");
constexpr size_t HALFROWS = (size_t)MTOK * 512 * 2;
constexpr size_t ZBYTES = (size_t)MTOK * INC * 2;
static_assert(ZBYTES + HALFROWS + 4 * MiB <= WS_END - WS_C && (size_t)MTOK * FF * 2 <= WS_END - WS_C, "region C");
constexpr size_t O_YP = 0, O_YS = (size_t)NTOK_P * DM, O_KP = O_YS + (size_t)NTOK_S * DM, O_VP = O_KP + 2 * 8 * 128 * 128, O_HRP = O_VP + 2 * 8 * 128 * 128,
                 O_HIP = O_HRP + 2 * 8 * 32 * 64, O_KS = O_HIP + 2 * 8 * 32 * 64, O_VS = O_KS + (size_t)2 * 128 * 128 * 128, O_HRS = O_VS + (size_t)2 * 128 * 128 * 128,
                 O_HIS = O_HRS + 2 * 128 * 32 * 64, O_END = O_HIS + 2 * 128 * 32 * 64;
constexpr int LDS_BYTES = 147456;

__device__ __forceinline__ float bf2f(unsigned short b) { return __uint_as_float(((unsigned)b) << 16); }
__device__ __forceinline__ float bflo(unsigned w) { return __uint_as_float(w << 16); }
__device__ __forceinline__ float bfhi(unsigned w) { return __uint_as_float(w & 0xffff0000u); }
__device__ __forceinline__ unsigned pk2(float lo, float hi) { return pg8::cvt_pk_bf16(lo, hi); }
__device__ __forceinline__ unsigned short f2bf(float f) { return (unsigned short)(pg8::cvt_pk_bf16(f, 0.f) & 0xffffu); }
__device__ __forceinline__ float sigm(float x) { return __builtin_amdgcn_rcpf(1.f + __builtin_amdgcn_exp2f(-LOG2E * x)); }
__device__ __forceinline__ float gelu_tanh(float y) { const float y2 = y * y, t = y * (-2.f * 0.7978845608028654f * LOG2E - (2.f * 0.7978845608028654f * 0.044715f * LOG2E) * y2);
    return y * __builtin_amdgcn_rcpf(1.f + __builtin_amdgcn_exp2f(t)); }
__device__ __forceinline__ void unpack8(const u32x4 w, float (&f)[8]) { f[0] = bflo(w.x); f[1] = bfhi(w.x); f[2] = bflo(w.y); f[3] = bfhi(w.y); f[4] = bflo(w.z); f[5] = bfhi(w.z); f[6] = bflo(w.w); f[7] = bfhi(w.w); }
__device__ __forceinline__ int opq(int v) { asm volatile("" : "+v"(v)); return v; }
__device__ __forceinline__ float wave_sum(float v) {
#pragma unroll
    for (int o = 1; o < 64; o <<= 1) v += __shfl_xor(v, o);
    return v;
}

struct EpiIn {
    static constexpr bool PERM = true, AFTER_DRAIN = false;
    bf16_t* Z; const float* ss; const float* bgate; int pn0;
    struct Pre { float ssv; f32x4 b; };
    __device__ __forceinline__ void prefetch4(int row, int col, Pre& p) const { p.ssv = ss[row]; p.b = col >= ZG ? *(const f32x4*)(bgate + (col - ZG)) : (f32x4){0.f, 0.f, 0.f, 0.f}; }
    __device__ __forceinline__ void apply4(int row, int col, f32x4 v, const Pre& p) const {
        const float rs = rsqrtf(p.ssv * (1.f / DM) + EPS); v = v * rs;
        if (col >= ZG) { const f32x4 b = p.b; v = (f32x4){sigm(v[0] + b[0]), sigm(v[1] + b[1]), sigm(v[2] + b[2]), sigm(v[3] + b[3])}; }
        u32x2 w; w.x = pk2(v[0], v[1]); w.y = pk2(v[2], v[3]); *(u32x2*)(Z + (size_t)row * INC + col) = w;
    }
    __device__ __forceinline__ void operator()(const f32x4 (&acc)[2][2][4][2], const Unit& u, int wr, int wc, int fr, int fq) const {
        const int row0 = u.pm * 256 + wr * 64 + fr, col0 = (u.pn + pn0) * 256 + wc * 32 + 8 * fq; const bool gate = u.pn + pn0 >= 5;
        f32x4 bv[2][2];
#pragma unroll
        for (int bj = 0; bj < 2; ++bj)
#pragma unroll
            for (int n = 0; n < 2; ++n) bv[bj][n] = gate ? *(const f32x4*)(bgate + (col0 - ZG) + bj * 128 + 4 * n) : (f32x4){0.f, 0.f, 0.f, 0.f};
        float rsv[2][4];
#pragma unroll
        for (int ai = 0; ai < 2; ++ai)
#pragma unroll
            for (int m = 0; m < 4; ++m) rsv[ai][m] = ss[row0 + ai * 128 + m * 16];
        __builtin_amdgcn_sched_barrier(0);
#pragma unroll
        for (int ai = 0; ai < 2; ++ai)
#pragma unroll
            for (int m = 0; m < 4; ++m) { const int row = row0 + ai * 128 + m * 16; const float rs = rsqrtf(rsv[ai][m] * (1.f / DM) + EPS); bf16_t* rowp = Z + (size_t)row * INC + col0;
#pragma unroll
                for (int bj = 0; bj < 2; ++bj) { f32x4 v0 = acc[ai][bj][m][0] * rs + bv[bj][0], v1 = acc[ai][bj][m][1] * rs + bv[bj][1];
                    if (gate) { v0 = (f32x4){sigm(v0[0]), sigm(v0[1]), sigm(v0[2]), sigm(v0[3])}; v1 = (f32x4){sigm(v1[0]), sigm(v1[1]), sigm(v1[2]), sigm(v1[3])}; }
                    u32x4 w; w.x = pk2(v0[0], v0[1]); w.y = pk2(v0[2], v0[3]); w.z = pk2(v1[0], v1[1]); w.w = pk2(v1[2], v1[3]);
                    *(u32x4*)(rowp + bj * 128) = w; } }
    }
};
struct EpiGlu {
    static constexpr bool PERM = true, AFTER_DRAIN = false;
    const bf16_t* Y; bf16_t* O; const float* b;
    struct Pre { u32x2 yw; f32x4 bb; };
    __device__ __forceinline__ void prefetch4(int row, int col, Pre& p) const { p.yw = *(const u32x2*)(Y + (size_t)row * 512 + col); p.bb = *(const f32x4*)(b + col); }
    __device__ __forceinline__ void apply4(int row, int col, f32x4 v, const Pre& p) const {
        const u32x2 yw = p.yw; const f32x4 bb = p.bb;
        u32x2 w; w.x = pk2(bflo(yw.x) * sigm(v[0] + bb[0]), bfhi(yw.x) * sigm(v[1] + bb[1])); w.y = pk2(bflo(yw.y) * sigm(v[2] + bb[2]), bfhi(yw.y) * sigm(v[3] + bb[3]));
        *(u32x2*)(O + (size_t)row * 512 + col) = w;
    }
    __device__ __forceinline__ void operator()(const f32x4 (&acc)[2][2][4][2], const Unit& u, int wr, int wc, int fr, int fq) const {
        const int row0 = u.pm * 256 + wr * 64 + fr, col0 = u.pn * 256 + wc * 32 + 8 * fq;
        f32x4 bv[2][2];
#pragma unroll
        for (int bj = 0; bj < 2; ++bj)
#pragma unroll
            for (int n = 0; n < 2; ++n) bv[bj][n] = *(const f32x4*)(b + col0 + bj * 128 + 4 * n);
#pragma unroll
        for (int ai = 0; ai < 2; ++ai) {
            u32x4 yraw[4][2];
#pragma unroll
            for (int m = 0; m < 4; ++m)
#pragma unroll
                for (int bj = 0; bj < 2; ++bj) yraw[m][bj] = *(const u32x4*)(Y + (size_t)(row0 + ai * 128 + m * 16) * 512 + col0 + bj * 128);
            __builtin_amdgcn_sched_barrier(0);
#pragma unroll
            for (int m = 0; m < 4; ++m) { const size_t off = (size_t)(row0 + ai * 128 + m * 16) * 512 + col0;
#pragma unroll
                for (int bj = 0; bj < 2; ++bj) { const f32x4 v0 = acc[ai][bj][m][0] + bv[bj][0], v1 = acc[ai][bj][m][1] + bv[bj][1];
                    float y[8]; unpack8(yraw[m][bj], y);
                    u32x4 w; w.x = pk2(y[0] * sigm(v0[0]), y[1] * sigm(v0[1])); w.y = pk2(y[2] * sigm(v0[2]), y[3] * sigm(v0[3]));
                    w.z = pk2(y[4] * sigm(v1[0]), y[5] * sigm(v1[1])); w.w = pk2(y[6] * sigm(v1[2]), y[7] * sigm(v1[3]));
                    *(u32x4*)(O + off + bj * 128) = w; } } }
    }
};
template <bool SECOND> struct EpiMix {
    static constexpr bool PERM = true, AFTER_DRAIN = false;
    const bf16_t* Zg; bf16_t* O;
    struct Pre { u32x2 gw, pw; };
    __device__ __forceinline__ void prefetch4(int row, int col, Pre& p) const { p.gw = *(const u32x2*)(Zg + (size_t)row * INC + col); if (SECOND) p.pw = *(const u32x2*)(O + (size_t)row * DM + col); }
    __device__ __forceinline__ void apply4(int row, int col, f32x4 v, const Pre& p) const {
        const u32x2 gw = p.gw; bf16_t* op = O + (size_t)row * DM + col;
        v = (f32x4){bflo(gw.x) * v[0], bfhi(gw.x) * v[1], bflo(gw.y) * v[2], bfhi(gw.y) * v[3]};
        if (SECOND) { const u32x2 pw = p.pw; v = v + (f32x4){bflo(pw.x), bfhi(pw.x), bflo(pw.y), bfhi(pw.y)}; }
        u32x2 w; w.x = pk2(v[0], v[1]); w.y = pk2(v[2], v[3]); *(u32x2*)op = w;
    }
    __device__ __forceinline__ void operator()(const f32x4 (&acc)[2][2][4][2], const Unit& u, int wr, int wc, int fr, int fq) const {
        const int row0 = u.pm * 256 + wr * 64 + fr, col0 = u.pn * 256 + wc * 32 + 8 * fq;
#pragma unroll
        for (int ai = 0; ai < 2; ++ai) {
            u32x4 graw[4][2], praw[4][2];
#pragma unroll
            for (int m = 0; m < 4; ++m)
#pragma unroll
                for (int bj = 0; bj < 2; ++bj) { const int row = row0 + ai * 128 + m * 16; graw[m][bj] = *(const u32x4*)(Zg + (size_t)row * INC + col0 + bj * 128);
                    if (SECOND) praw[m][bj] = *(const u32x4*)(O + (size_t)row * DM + col0 + bj * 128); }
            __builtin_amdgcn_sched_barrier(0);
#pragma unroll
            for (int m = 0; m < 4; ++m) { const int row = row0 + ai * 128 + m * 16;
#pragma unroll
                for (int bj = 0; bj < 2; ++bj) { const f32x4 a0 = acc[ai][bj][m][0], a1 = acc[ai][bj][m][1];
                    float g[8]; unpack8(graw[m][bj], g);
                    float v[8] = {g[0] * a0[0], g[1] * a0[1], g[2] * a0[2], g[3] * a0[3], g[4] * a1[0], g[5] * a1[1], g[6] * a1[2], g[7] * a1[3]};
                    bf16_t* op = O + (size_t)row * DM + col0 + bj * 128;
                    if (SECOND) { float p[8]; unpack8(praw[m][bj], p);
#pragma unroll
                        for (int k = 0; k < 8; ++k) v[k] += p[k]; }
                    u32x4 w; w.x = pk2(v[0], v[1]); w.y = pk2(v[2], v[3]); w.z = pk2(v[4], v[5]); w.w = pk2(v[6], v[7]);
                    *(u32x4*)op = w; } } }
    }
};
struct EpiRes {
    static constexpr bool PERM = true, AFTER_DRAIN = false;
    const bf16_t* base; bf16_t* XB; float* Xf; float* ss;
    struct Pre { u32x2 bw; };
    __device__ __forceinline__ void prefetch4(int row, int col, Pre& p) const { p.bw = *(const u32x2*)(base + (size_t)row * DM + col); }
    __device__ __forceinline__ void apply4(int row, int col, f32x4 v, const Pre& p) const {
        const size_t off = (size_t)row * DM + col; const u32x2 bw = p.bw;
        v = v + (f32x4){bflo(bw.x), bfhi(bw.x), bflo(bw.y), bfhi(bw.y)};
        if (Xf) *(f32x4*)(Xf + off) = v;
        if (XB) { u32x2 w; w.x = pk2(v[0], v[1]); w.y = pk2(v[2], v[3]); *(u32x2*)(XB + off) = w; }
        if (ss) { float sq = (v[0] * v[0] + v[1] * v[1]) + (v[2] * v[2] + v[3] * v[3]); sq += __shfl_xor(sq, 1); sq += __shfl_xor(sq, 2); sq += __shfl_xor(sq, 4); if ((threadIdx.x & 7) == 0) atomicAdd(ss + row, sq); }
    }
    __device__ __forceinline__ void operator()(const f32x4 (&acc)[2][2][4][2], const Unit& u, int wr, int wc, int fr, int fq) const {
        const int row0 = u.pm * 256 + wr * 64 + fr, col0 = u.pn * 256 + wc * 32 + 8 * fq;
#pragma unroll
        for (int ai = 0; ai < 2; ++ai) {
            u32x4 braw[4][2];
#pragma unroll
            for (int m = 0; m < 4; ++m)
#pragma unroll
                for (int bj = 0; bj < 2; ++bj) braw[m][bj] = *(const u32x4*)(base + (size_t)(row0 + ai * 128 + m * 16) * DM + col0 + bj * 128);
            __builtin_amdgcn_sched_barrier(0);
#pragma unroll
            for (int m = 0; m < 4; ++m) { const int row = row0 + ai * 128 + m * 16; const size_t off = (size_t)row * DM + col0; float sq = 0.f;
#pragma unroll
                for (int bj = 0; bj < 2; ++bj) { float b[8]; unpack8(braw[m][bj], b);
                    const f32x4 a0 = acc[ai][bj][m][0], a1 = acc[ai][bj][m][1];
                    const f32x4 v0 = (f32x4){b[0] + a0[0], b[1] + a0[1], b[2] + a0[2], b[3] + a0[3]}, v1 = (f32x4){b[4] + a1[0], b[5] + a1[1], b[6] + a1[2], b[7] + a1[3]};
                    sq += (v0[0] * v0[0] + v0[1] * v0[1]) + (v0[2] * v0[2] + v0[3] * v0[3]) + (v1[0] * v1[0] + v1[1] * v1[1]) + (v1[2] * v1[2] + v1[3] * v1[3]);
                    if (Xf) { *(f32x4*)(Xf + off + bj * 128) = v0; *(f32x4*)(Xf + off + bj * 128 + 4) = v1; }
                    if (XB) { u32x4 w; w.x = pk2(v0[0], v0[1]); w.y = pk2(v0[2], v0[3]); w.z = pk2(v1[0], v1[1]); w.w = pk2(v1[2], v1[3]); *(u32x4*)(XB + off + bj * 128) = w; } }
                if (ss) { sq += __shfl_xor(sq, 16); sq += __shfl_xor(sq, 32); if (fq == 0) atomicAdd(ss + row, sq); } } }
    }
};
struct EpiUp {
    static constexpr bool PERM = true, AFTER_DRAIN = false;
    bf16_t* H; const float* ss; const LAS float* rsl;
    struct Pre { float ssv; };
    __device__ __forceinline__ void prefetch4(int row, int col, Pre& p) const { p.ssv = ss[row]; }
    __device__ __forceinline__ void apply4(int row, int col, f32x4 v, const Pre& p) const {
        const float rs = rsqrtf(p.ssv * (1.f / DM) + EPS);
#pragma unroll
        for (int k = 0; k < 4; ++k) { const float t = fmaxf(v[k] * rs, 0.f); v[k] = t * t; }
        u32x2 w; w.x = pk2(v[0], v[1]); w.y = pk2(v[2], v[3]); *(u32x2*)(H + (size_t)row * FF + col) = w;
    }
    __device__ __forceinline__ void operator()(const f32x4 (&acc)[2][2][4][2], const Unit& u, int wr, int wc, int fr, int fq) const {
        const int row0 = u.pm * 256 + wr * 64 + fr, col0 = u.pn * 256 + wc * 32 + 8 * fq;
        float rsv[2][4];
#pragma unroll
        for (int ai = 0; ai < 2; ++ai)
#pragma unroll
            for (int m = 0; m < 4; ++m) rsv[ai][m] = rsl[u.slot * 256 + wr * 64 + fr + ai * 128 + m * 16];
        __builtin_amdgcn_sched_barrier(0);
#pragma unroll
        for (int ai = 0; ai < 2; ++ai)
#pragma unroll
            for (int m = 0; m < 4; ++m) { const int row = row0 + ai * 128 + m * 16; const float rs = rsv[ai][m]; bf16_t* rowp = H + (size_t)row * FF + col0;
#pragma unroll
                for (int bj = 0; bj < 2; ++bj) { f32x4 v0 = acc[ai][bj][m][0] * rs, v1 = acc[ai][bj][m][1] * rs;
#pragma unroll
                    for (int k = 0; k < 4; ++k) { const float a = fmaxf(v0[k], 0.f), b = fmaxf(v1[k], 0.f); v0[k] = a * a; v1[k] = b * b; }
                    u32x4 w; w.x = pk2(v0[0], v0[1]); w.y = pk2(v0[2], v0[3]); w.z = pk2(v1[0], v1[1]); w.w = pk2(v1[2], v1[3]);
                    *(u32x4*)(rowp + bj * 128) = w; } }
    }
};

struct SlotOrder : pg8::StaticOrder {
    __device__ __forceinline__ bool next(int i, Unit& u) const { const bool ok = pg8::StaticOrder::next(i, u); u.slot = i; return ok; }
};
template <int CT, class Epi> __device__ __forceinline__ void skinny_gemm(LAS unsigned char* lds, const bf16_t* A, const bf16_t* Bt, int N, int K, const Epi& E, int first) {
    const int tid = opq(threadIdx.x), lane = tid & 63, wave = __builtin_amdgcn_readfirstlane(tid >> 6), r = lane & 15, qd = lane >> 4;
    const int G = gridDim.x, nunits = 8 * (N / (16 * CT)), kw = K / 8, nsteps = kw / 32;
    LAS float* red = (LAS float*)lds;
    for (int u = (int)((blockIdx.x + G - first % G) % G); u < nunits; u += G) {
        const int mt = u & 7, nt = u >> 3;
        const bf16_t* ap = A + (size_t)(NTOK_P + mt * 64 + r) * K + wave * kw + 8 * qd;
        const bf16_t* bp = Bt + (size_t)(nt * 16 * CT + r) * K + wave * kw + 8 * qd;
        typename Epi::Pre pre[CT / 2];
#pragma unroll
        for (int e = 0; e < CT / 2; ++e) { const int idx = tid + e * 512; E.prefetch4(NTOK_P + mt * 64 + idx / (4 * CT), nt * 16 * CT + (idx % (4 * CT)) * 4, pre[e]); }
        f32x4 acc[4][CT];
#pragma unroll
        for (int rt = 0; rt < 4; ++rt)
#pragma unroll
            for (int ct = 0; ct < CT; ++ct) acc[rt][ct] = (f32x4){0.f, 0.f, 0.f, 0.f};
#define SKINNY_GROUP(GS, S0) do { bf16x8 af_[GS][4], bf_[GS][CT]; \
            _Pragma("unroll") for (int q_ = 0; q_ < GS; ++q_) { \
                _Pragma("unroll") for (int rt = 0; rt < 4; ++rt) af_[q_][rt] = *(const bf16x8*)(ap + (size_t)rt * 16 * K + ((S0) + q_) * 32); \
                _Pragma("unroll") for (int ct = 0; ct < CT; ++ct) bf_[q_][ct] = *(const bf16x8*)(bp + (size_t)ct * 16 * K + ((S0) + q_) * 32); } \
            __builtin_amdgcn_sched_barrier(0); \
            _Pragma("unroll") for (int q_ = 0; q_ < GS; ++q_) \
                _Pragma("unroll") for (int rt = 0; rt < 4; ++rt) \
                    _Pragma("unroll") for (int ct = 0; ct < CT; ++ct) acc[rt][ct] = __builtin_amdgcn_mfma_f32_16x16x32_bf16(bf_[q_][ct], af_[q_][rt], acc[rt][ct], 0, 0, 0); \
            __builtin_amdgcn_sched_barrier(0); } while (0)
        if (nsteps >= 4) {
#pragma unroll 1
            for (int s0 = 0; s0 < nsteps; s0 += 4) SKINNY_GROUP(4, s0);
        } else SKINNY_GROUP(2, 0);
#undef SKINNY_GROUP
#pragma unroll
        for (int rt = 0; rt < 4; ++rt)
#pragma unroll
            for (int ct = 0; ct < CT; ++ct) *(LAS f32x4*)(red + wave * (64 * 16 * CT) + (rt * 16 + r) * (16 * CT) + ct * 16 + 4 * qd) = acc[rt][ct];
        __syncthreads();
#pragma unroll
        for (int e = 0; e < CT / 2; ++e) { const int idx = tid + e * 512, row = idx / (4 * CT), c4 = idx % (4 * CT);
            f32x4 v = *(const LAS f32x4*)(red + row * (16 * CT) + c4 * 4);
#pragma unroll
            for (int w = 1; w < 8; ++w) v = v + *(const LAS f32x4*)(red + w * (64 * 16 * CT) + row * (16 * CT) + c4 * 4);
            E.apply4(NTOK_P + mt * 64 + row, nt * 16 * CT + c4 * 4, v, pre[e]); }
        __syncthreads();
    }
}

struct Args { const float* in[28]; float* out; unsigned char* ws; };
enum { I_XP = 0, I_XS, I_CK, I_CV, I_SR, I_SI, I_N1G, I_WIN, I_BG, I_QG, I_KG, I_SINK, I_LRE, I_LIM, I_LSTEP, I_BRE, I_BIM, I_CRE, I_CIM, I_DSK, I_WGLU, I_BGLU, I_WAO, I_WSO, I_WOUT, I_N2G, I_WUP, I_WDN };

struct TItem { const float* W; const float* gain; bf16_t* WT; int K, N, k0, n0; };
__device__ __forceinline__ TItem titem(const Args& a, int it) {
    constexpr int I0 = (DM / 64) * (INC / 256), I1 = (512 / 64) * (512 / 256), I2 = (512 / 64) * (1024 / 256), I3 = I2, I4 = (DM / 64) * (DM / 256), I5 = (DM / 64) * (FF / 256), I6 = (FF / 64) * (DM / 256);
    constexpr int IL = I0 + I1 + I2 + I3 + I4 + I5 + I6;
    const int l = it / IL; int r = it % IL; bf16_t* Wl = (bf16_t*)(a.ws + WS_W) + (size_t)l * W_LAYER; TItem t;
    if (r < I0) { t.W = a.in[I_WIN] + (size_t)l * DM * INC; t.gain = a.in[I_N1G] + l * DM; t.WT = Wl + W_IN; t.K = DM; t.N = INC; }
    else if ((r -= I0) < I1) { t.W = a.in[I_WGLU] + (size_t)l * 512 * 512; t.gain = nullptr; t.WT = Wl + W_GLU; t.K = 512; t.N = 512; }
    else if ((r -= I1) < I2) { t.W = a.in[I_WAO] + (size_t)l * 512 * 1024; t.gain = nullptr; t.WT = Wl + W_AO; t.K = 512; t.N = 1024; }
    else if ((r -= I2) < I3) { t.W = a.in[I_WSO] + (size_t)l * 512 * 1024; t.gain = nullptr; t.WT = Wl + W_SO; t.K = 512; t.N = 1024; }
    else if ((r -= I3) < I4) { t.W = a.in[I_WOUT] + (size_t)l * DM * DM; t.gain = nullptr; t.WT = Wl + W_OUT; t.K = DM; t.N = DM; }
    else if ((r -= I4) < I5) { t.W = a.in[I_WUP] + (size_t)l * DM * FF; t.gain = a.in[I_N2G] + l * DM; t.WT = Wl + W_UP; t.K = DM; t.N = FF; }
    else { r -= I5; t.W = a.in[I_WDN] + (size_t)l * FF * DM; t.gain = nullptr; t.WT = Wl + W_DN; t.K = FF; t.N = DM; }
    const int nblk = t.N / 256; t.k0 = 64 * (r / nblk); t.n0 = 256 * (r % nblk);
    return t;
}
constexpr int T_ITEMS = 2 * ((DM / 64) * (INC / 256) + (512 / 64) * (512 / 256) + 2 * (512 / 64) * (1024 / 256) + (DM / 64) * (DM / 256) + (DM / 64) * (FF / 256) + (FF / 64) * (DM / 256));
__device__ __forceinline__ void prologue(const Args& a, LAS unsigned char* lds, int tid, int wave, int lane) {
    unsigned char* ws = a.ws;
    const int gw = blockIdx.x * 8 + wave, NGW = gridDim.x * 8;
    {   constexpr int TS = 257; LAS float* tile = (LAS float*)lds;
        f32x4 v[8]; int it = blockIdx.x;
        if (it < T_ITEMS) { const TItem t = titem(a, it);
#pragma unroll
            for (int i = 0; i < 8; ++i) { v[i] = __builtin_nontemporal_load((const f32x4*)(t.W + (size_t)(t.k0 + 8 * wave + i) * t.N + t.n0 + 4 * lane)); if (t.gain) v[i] = v[i] * t.gain[t.k0 + 8 * wave + i]; } }
        for (; it < T_ITEMS; it += gridDim.x) {
            const TItem t = titem(a, it);
#pragma unroll
            for (int i = 0; i < 8; ++i) { LAS float* tp = tile + (8 * wave + i) * TS + 4 * lane; tp[0] = v[i][0]; tp[1] = v[i][1]; tp[2] = v[i][2]; tp[3] = v[i][3]; }
            __syncthreads();
            if (it + (int)gridDim.x < T_ITEMS) { const TItem tn = titem(a, it + gridDim.x);
#pragma unroll
                for (int i = 0; i < 8; ++i) { v[i] = __builtin_nontemporal_load((const f32x4*)(tn.W + (size_t)(tn.k0 + 8 * wave + i) * tn.N + tn.n0 + 4 * lane)); if (tn.gain) v[i] = v[i] * tn.gain[tn.k0 + 8 * wave + i]; } }
#pragma unroll
            for (int j = 0; j < 4; ++j) { const int q = tid + 512 * j, n = q >> 3, c = q & 7; const LAS float* s = tile + (8 * c) * TS + n;
                u32x4 o; o.x = pk2(s[0 * TS], s[1 * TS]); o.y = pk2(s[2 * TS], s[3 * TS]); o.z = pk2(s[4 * TS], s[5 * TS]); o.w = pk2(s[6 * TS], s[7 * TS]);
                *(u32x4*)(t.WT + (size_t)(t.n0 + n) * t.K + t.k0 + 8 * c) = o; }
            __syncthreads();
        }
    }
    float* ss = (float*)(ws + WS_SS); bf16_t* XB = (bf16_t*)(ws + WS_A);
    for (int m = gw; m < MTOK; m += NGW) {
        const float* src = (m < NTOK_P) ? a.in[I_XP] + (size_t)m * DM : a.in[I_XS] + (size_t)(m - NTOK_P) * DM;
        f32x4 v[4]; float s = 0.f;
#pragma unroll
        for (int j = 0; j < 4; ++j) { v[j] = __builtin_nontemporal_load((const f32x4*)src + lane + 64 * j); s += (v[j][0] * v[j][0] + v[j][1] * v[j][1]) + (v[j][2] * v[j][2] + v[j][3] * v[j][3]); }
        s = wave_sum(s);
#pragma unroll
        for (int j = 0; j < 4; ++j) { u32x2 w; w.x = pk2(v[j][0], v[j][1]); w.y = pk2(v[j][2], v[j][3]); *((u32x2*)(XB + (size_t)m * DM) + lane + 64 * j) = w; }
        if (lane == 0) ss[m] = s;
    }
    for (int i = blockIdx.x * 512 + tid; i < 3 * MTOK; i += gridDim.x * 512) ss[MTOK + i] = 0.f;
    for (int i = tid < 16 ? (int)blockIdx.x * 16 + tid : 2 * NG * NP; i < 2 * NG * NP; i += gridDim.x * 16) {
        const int l = i / (NG * NP), g = (i / NP) % NG, p = i % NP;
        const float lre = a.in[I_LRE][i], lim = a.in[I_LIM][i], step = expf(a.in[I_LSTEP][l * NG + g]);
        const float mag = expf(lre * step), ar = mag * cosf(lim * step), ai = mag * sinf(lim * step), den = lre * lre + lim * lim;
        const float cr = ((ar - 1.f) * lre + ai * lim) / den, ci = (ai * lre - (ar - 1.f) * lim) / den;
        float pr = ar, pi = ai;
#pragma unroll
        for (int k = 0; k < 8; ++k) { const float nr = pr * pr - pi * pi, ni = 2.f * pr * pi; pr = nr; pi = ni; }
        ((f32x4*)(ws + WS_TA))[i] = (f32x4){ar, ai, pr, pi};
        bf16_t* tbh = (bf16_t*)(ws + WS_TB) + (size_t)(l * NG + g) * 128 * GC;
        const float* bre = a.in[I_BRE] + (size_t)i * GC; const float* bim = a.in[I_BIM] + (size_t)i * GC;
#pragma unroll
        for (int c = 0; c < GC; c += 2) { const float br0 = bre[c], bi0 = bim[c], br1 = bre[c + 1], bi1 = bim[c + 1];
            *(unsigned*)(tbh + (2 * p) * GC + c) = pk2(cr * br0 - ci * bi0, cr * br1 - ci * bi1); *(unsigned*)(tbh + (2 * p + 1) * GC + c) = pk2(cr * bi0 + ci * br0, cr * bi1 + ci * br1); }
        bf16_t* tc = (bf16_t*)(ws + WS_TC) + (size_t)(l * NG + g) * GC * 128;
        const float* cre = a.in[I_CRE] + (size_t)(l * NG + g) * GC * NP; const float* cim = a.in[I_CIM] + (size_t)(l * NG + g) * GC * NP;
#pragma unroll
        for (int c = 0; c < GC; ++c) *(unsigned*)(tc + c * 128 + 2 * p) = pk2(cre[c * NP + p], -cim[c * NP + p]);
    }
}

__device__ __forceinline__ void attn_prompt_unit(const Args& a, LAS unsigned char* lds, int l, int b, int qb, int kvh, int tid) {
    constexpr int KST = 72, VST = 272;
    LAS bf16_t* Ks = (LAS bf16_t*)lds; LAS bf16_t* Vt = Ks + 256 * KST; LAS float* kmaxs = (LAS float*)(Vt + 64 * VST);
    const bf16_t* Z = (const bf16_t*)(a.ws + WS_C);
    const float* gk = a.in[I_KG] + l * 64; const float* gq = a.in[I_QG] + l * 64;
    const int wave = tid >> 6, lane = tid & 63, r = lane & 15, qd = lane >> 4, g = wave >> 1, qh = wave & 1, h = kvh * 4 + g;
    const size_t qrow0 = (size_t)b * SEQ + qb * WIN + qh * 64;
    u32x4 qraw[4][2];
#pragma unroll
    for (int qt = 0; qt < 4; ++qt) { const bf16_t* zq = Z + (qrow0 + qt * 16 + r) * INC + ZQ + h * 64 + 8 * qd; qraw[qt][0] = *(const u32x4*)zq; qraw[qt][1] = *(const u32x4*)(zq + 32); }
    f32x4 gkv[8], gqv[4];
#pragma unroll
    for (int c = 0; c < 8; ++c) gkv[c] = *(const f32x4*)(gk + (tid & 1) * 32 + 4 * c);
#pragma unroll
    for (int c = 0; c < 4; ++c) gqv[c] = *(const f32x4*)(gq + (c >> 1) * 32 + 8 * qd + 4 * (c & 1));
    {
        const int j = tid >> 1, half = tid & 1, pos = (qb - 1) * WIN + j; const bool valid = pos >= 0;
        float kf[32]; u32x4 vraw[4];
        if (valid) { const bf16_t* zr = Z + (size_t)(b * SEQ + pos) * INC + kvh * 64 + half * 32;
#pragma unroll
            for (int c = 0; c < 4; ++c) { float t8[8]; unpack8(*(const u32x4*)(zr + ZK + c * 8), t8);
#pragma unroll
                for (int k = 0; k < 8; ++k) kf[c * 8 + k] = t8[k];
                vraw[c] = *(const u32x4*)(zr + ZV + c * 8); }
        } else {
#pragma unroll
            for (int k = 0; k < 32; ++k) kf[k] = 0.f;
#pragma unroll
            for (int c = 0; c < 4; ++c) vraw[c] = (u32x4){0u, 0u, 0u, 0u}; }
        float sq = 0.f;
#pragma unroll
        for (int k = 0; k < 32; ++k) sq += kf[k] * kf[k];
        sq += __shfl_xor(sq, 1);
        const float rs = rsqrtf(sq * (1.f / 64.f) + EPS); float n2 = 0.f;
#pragma unroll
        for (int k = 0; k < 32; ++k) { kf[k] = kf[k] * rs * gkv[k >> 2][k & 3]; n2 += kf[k] * kf[k]; }
        n2 += __shfl_xor(n2, 1);
        { float wm = n2;
#pragma unroll
          for (int o = 1; o < 64; o <<= 1) wm = fmaxf(wm, __shfl_xor(wm, o));
          if (lane == 0) kmaxs[wave] = sqrtf(wm); }
#pragma unroll
        for (int c = 0; c < 4; ++c) { u32x4 w; w.x = pk2(kf[8 * c], kf[8 * c + 1]); w.y = pk2(kf[8 * c + 2], kf[8 * c + 3]); w.z = pk2(kf[8 * c + 4], kf[8 * c + 5]); w.w = pk2(kf[8 * c + 6], kf[8 * c + 7]);
            *(LAS u32x4*)(Ks + j * KST + half * 32 + c * 8) = w; }
#pragma unroll
        for (int c = 0; c < 4; ++c) { const unsigned w4[4] = {vraw[c].x, vraw[c].y, vraw[c].z, vraw[c].w};
#pragma unroll
            for (int k = 0; k < 4; ++k) { Vt[(half * 32 + c * 8 + 2 * k) * VST + j] = (bf16_t)(w4[k] & 0xffffu); Vt[(half * 32 + c * 8 + 2 * k + 1) * VST + j] = (bf16_t)(w4[k] >> 16); } }
        if (qb == SEQ / WIN - 1 && j >= WIN) {
            float* ko = a.out + O_KP + ((((size_t)l * NBATCH + b) * WIN + (j - WIN)) * 2 + kvh) * 64 + half * 32;
            float* vo = a.out + O_VP + ((((size_t)l * NBATCH + b) * WIN + (j - WIN)) * 2 + kvh) * 64 + half * 32;
#pragma unroll
            for (int c = 0; c < 8; ++c) *(f32x4*)(ko + 4 * c) = (f32x4){kf[4 * c], kf[4 * c + 1], kf[4 * c + 2], kf[4 * c + 3]};
#pragma unroll
            for (int c = 0; c < 4; ++c) { *(f32x4*)(vo + 8 * c) = (f32x4){bflo(vraw[c].x), bfhi(vraw[c].x), bflo(vraw[c].y), bfhi(vraw[c].y)}; *(f32x4*)(vo + 8 * c + 4) = (f32x4){bflo(vraw[c].z), bfhi(vraw[c].z), bflo(vraw[c].w), bfhi(vraw[c].w)}; }
        }
    }
    __syncthreads();
    float kmax = kmaxs[0];
#pragma unroll
    for (int w = 1; w < 8; ++w) kmax = fmaxf(kmax, kmaxs[w]);
    const float cs = 0.125f * LOG2E, sinkl = a.in[I_SINK][l * 8 + h] * LOG2E, slope = exp2f(-(float)(h + 1)) * LOG2E;
    bf16x8 qf[4][2]; float mref[4];
#pragma unroll
    for (int qt = 0; qt < 4; ++qt) {
        float x[16]; { float t8[8]; unpack8(qraw[qt][0], t8);
#pragma unroll
            for (int k = 0; k < 8; ++k) x[k] = t8[k];
            unpack8(qraw[qt][1], t8);
#pragma unroll
            for (int k = 0; k < 8; ++k) x[8 + k] = t8[k]; }
        float sq = 0.f;
#pragma unroll
        for (int k = 0; k < 16; ++k) sq += x[k] * x[k];
        sq += __shfl_xor(sq, 16); sq += __shfl_xor(sq, 32);
        const float rs = rsqrtf(sq * (1.f / 64.f) + EPS); float n2 = 0.f;
#pragma unroll
        for (int k = 0; k < 16; ++k) { x[k] = x[k] * rs * gqv[k >> 2][k & 3]; n2 += x[k] * x[k]; }
        n2 += __shfl_xor(n2, 16); n2 += __shfl_xor(n2, 32);
        mref[qt] = fmaxf(sinkl, sqrtf(n2) * kmax * cs);
#pragma unroll
        for (int s = 0; s < 2; ++s) { u32x4 w; w.x = pk2(x[8 * s] * cs, x[8 * s + 1] * cs); w.y = pk2(x[8 * s + 2] * cs, x[8 * s + 3] * cs); w.z = pk2(x[8 * s + 4] * cs, x[8 * s + 5] * cs); w.w = pk2(x[8 * s + 6] * cs, x[8 * s + 7] * cs);
            qf[qt][s] = __builtin_bit_cast(bf16x8, w); }
    }
    f32x4 O[4][4]; float lsum[4];
#pragma unroll
    for (int qt = 0; qt < 4; ++qt) { lsum[qt] = 0.f;
#pragma unroll
        for (int dt = 0; dt < 4; ++dt) O[qt][dt] = (f32x4){0.f, 0.f, 0.f, 0.f}; }
    const int base = r - 4 * qd;
#pragma unroll
    for (int qt = 0; qt < 4; ++qt) mref[qt] += slope * (float)base;
#pragma unroll 1
    for (int ks = (qb == 0 ? (4 - 2 * qh) : 0); ks < 6; ++ks) {
        const int J = qh * 64 + ks * 32, base2 = base - 32 * ks; const float sk = slope * (float)(32 * ks);
        bf16x8 kfr[2][2], vfr[4];
#pragma unroll
        for (int T = 0; T < 2; ++T)
#pragma unroll
            for (int s = 0; s < 2; ++s) kfr[T][s] = *(const LAS bf16x8*)(Ks + (J + 16 * T + r) * KST + 32 * s + 8 * qd);
#pragma unroll
        for (int dt = 0; dt < 4; ++dt) { const u32x2 lo = *(const LAS u32x2*)(Vt + (dt * 16 + r) * VST + J + 4 * qd), hi = *(const LAS u32x2*)(Vt + (dt * 16 + r) * VST + J + 16 + 4 * qd);
            vfr[dt] = __builtin_bit_cast(bf16x8, (u32x4){lo.x, lo.y, hi.x, hi.y}); }
#pragma unroll
        for (int qt = 0; qt < 4; ++qt) {
            if (ks * 32 + 31 >= qt * 16 && ks * 32 <= qt * 16 + 143) {
                f32x4 S[2];
#pragma unroll
                for (int T = 0; T < 2; ++T) { S[T] = __builtin_amdgcn_mfma_f32_16x16x32_bf16(kfr[T][0], qf[qt][0], (f32x4){0.f, 0.f, 0.f, 0.f}, 0, 0, 0); S[T] = __builtin_amdgcn_mfma_f32_16x16x32_bf16(kfr[T][1], qf[qt][1], S[T], 0, 0, 0); }
                const float mt = mref[qt] - sk; float p[2][4];
#pragma unroll
                for (int T = 0; T < 2; ++T)
#pragma unroll
                    for (int i = 0; i < 4; ++i) { const int cst = WIN + 16 * qt - 16 * T - i; const unsigned dist = (unsigned)(cst + base2);
                        const float e = __builtin_amdgcn_exp2f((S[T][i] - mt) - slope * (float)cst); p[T][i] = dist <= (unsigned)WIN ? e : 0.f; lsum[qt] += p[T][i]; }
                u32x4 w; w.x = pk2(p[0][0], p[0][1]); w.y = pk2(p[0][2], p[0][3]); w.z = pk2(p[1][0], p[1][1]); w.w = pk2(p[1][2], p[1][3]);
                const bf16x8 pf = __builtin_bit_cast(bf16x8, w);
#pragma unroll
                for (int dt = 0; dt < 4; ++dt) O[qt][dt] = __builtin_amdgcn_mfma_f32_16x16x32_bf16(vfr[dt], pf, O[qt][dt], 0, 0, 0);
            }
        }
    }
#pragma unroll
    for (int qt = 0; qt < 4; ++qt) mref[qt] -= slope * (float)base;
#pragma unroll
    for (int qt = 0; qt < 4; ++qt) {
        float ls = lsum[qt]; ls += __shfl_xor(ls, 16); ls += __shfl_xor(ls, 32);
        const float inv = 1.f / (ls + __builtin_amdgcn_exp2f(sinkl - mref[qt]));
        bf16_t* op = (bf16_t*)(a.ws + WS_B) + (qrow0 + qt * 16 + r) * 512 + h * 64 + 4 * qd;
#pragma unroll
        for (int dt = 0; dt < 4; ++dt) { u32x2 w; w.x = pk2(O[qt][dt][0] * inv, O[qt][dt][1] * inv); w.y = pk2(O[qt][dt][2] * inv, O[qt][dt][3] * inv); *(u32x2*)(op + dt * 16) = w; }
    }
    __syncthreads();
}
__device__ __forceinline__ void attn_sample_unit(const Args& a, LAS unsigned char* lds, int l, int b, int kvh, int tid) {
    constexpr int KST = 72, VST = 176, NKP = 160;
    LAS bf16_t* Ks = (LAS bf16_t*)lds; LAS bf16_t* Vt = Ks + NKP * KST;
    const bf16_t* Z = (const bf16_t*)(a.ws + WS_C);
    const float* gk = a.in[I_KG] + l * 64; const float* gq = a.in[I_QG] + l * 64;
    const float* ck = a.in[I_CK] + ((size_t)l * DEC_B + b) * WIN * 128 + kvh * 64; const float* cv = a.in[I_CV] + ((size_t)l * DEC_B + b) * WIN * 128 + kvh * 64;
    float* ko = a.out + O_KS + ((size_t)l * DEC_B + b) * WIN * 128 + kvh * 64; float* vo = a.out + O_VS + ((size_t)l * DEC_B + b) * WIN * 128 + kvh * 64;
    const size_t zrow0 = (size_t)NTOK_P + b * DEC_T;
    const int lane = tid & 63, r = lane & 15, qd = lane >> 4, t = r >> 2, h = kvh * 4 + (r & 3);
    u32x4 qraw[2];
    { const bf16_t* zq = Z + (zrow0 + t) * INC + ZQ + h * 64 + 8 * qd; qraw[0] = *(const u32x4*)zq; qraw[1] = *(const u32x4*)(zq + 32); }
    {
        f32x4 kv[4], vv[4];
#pragma unroll
        for (int k = 0; k < 4; ++k) { const int idx = tid + 512 * k, row = idx >> 4, c4 = idx & 15; kv[k] = *(const f32x4*)(ck + (size_t)row * 128 + c4 * 4); vv[k] = *(const f32x4*)(cv + (size_t)row * 128 + c4 * 4); }
        for (int i = tid; i < (NKP - WIN - DEC_T) * 64; i += 512) { const int row = WIN + DEC_T + (i >> 6), d = i & 63; Ks[row * KST + d] = 0; Vt[d * VST + row] = 0; }
#pragma unroll
        for (int k = 0; k < 4; ++k) { const int idx = tid + 512 * k, row = idx >> 4, c4 = idx & 15;
            u32x2 w; w.x = pk2(kv[k][0], kv[k][1]); w.y = pk2(kv[k][2], kv[k][3]); *(LAS u32x2*)(Ks + row * KST + c4 * 4) = w;
#pragma unroll
            for (int i = 0; i < 4; ++i) Vt[(c4 * 4 + i) * VST + row] = f2bf(vv[k][i]);
            if (row >= DEC_T) { *(f32x4*)(ko + (size_t)(row - DEC_T) * 128 + c4 * 4) = kv[k]; *(f32x4*)(vo + (size_t)(row - DEC_T) * 128 + c4 * 4) = vv[k]; } }
        if (tid < 256) { const int t2 = tid >> 6, d = tid & 63; const bf16_t* zr = Z + (zrow0 + t2) * INC + kvh * 64 + d;
            const float kr = bf2f(zr[ZK]), vr = bf2f(zr[ZV]); const float sq = wave_sum(kr * kr); const float kn = kr * rsqrtf(sq * (1.f / 64.f) + EPS) * gk[d];
            Ks[(WIN + t2) * KST + d] = f2bf(kn); Vt[d * VST + WIN + t2] = zr[ZV]; ko[(size_t)(WIN - DEC_T + t2) * 128 + d] = kn; vo[(size_t)(WIN - DEC_T + t2) * 128 + d] = vr; }
    }
    __syncthreads();
    if (tid < 64) {
        const float cs = 0.125f * LOG2E, sinkl = a.in[I_SINK][l * 8 + h] * LOG2E, slope = exp2f(-(float)(h + 1)) * LOG2E;
        bf16x8 qf[2];
        {   float x[16]; { float t8[8]; unpack8(qraw[0], t8);
#pragma unroll
                for (int k = 0; k < 8; ++k) x[k] = t8[k];
                unpack8(qraw[1], t8);
#pragma unroll
                for (int k = 0; k < 8; ++k) x[8 + k] = t8[k]; }
            float sq = 0.f;
#pragma unroll
            for (int k = 0; k < 16; ++k) sq += x[k] * x[k];
            sq += __shfl_xor(sq, 16); sq += __shfl_xor(sq, 32);
            const float rs = rsqrtf(sq * (1.f / 64.f) + EPS) * cs;
#pragma unroll
            for (int k = 0; k < 16; ++k) x[k] = x[k] * rs * gq[(k >> 3) * 32 + 8 * qd + (k & 7)];
#pragma unroll
            for (int s = 0; s < 2; ++s) { u32x4 w; w.x = pk2(x[8 * s], x[8 * s + 1]); w.y = pk2(x[8 * s + 2], x[8 * s + 3]); w.z = pk2(x[8 * s + 4], x[8 * s + 5]); w.w = pk2(x[8 * s + 6], x[8 * s + 7]);
                qf[s] = __builtin_bit_cast(bf16x8, w); } }
        f32x4 S[NKP / 16]; float mx = -1e30f;
#pragma unroll
        for (int T = 0; T < NKP / 16; ++T) {
            const bf16x8 k0 = *(const LAS bf16x8*)(Ks + (16 * T + r) * KST + 8 * qd), k1 = *(const LAS bf16x8*)(Ks + (16 * T + r) * KST + 32 + 8 * qd);
            S[T] = __builtin_amdgcn_mfma_f32_16x16x32_bf16(k0, qf[0], (f32x4){0.f, 0.f, 0.f, 0.f}, 0, 0, 0); S[T] = __builtin_amdgcn_mfma_f32_16x16x32_bf16(k1, qf[1], S[T], 0, 0, 0); }
#pragma unroll
        for (int T = 0; T < NKP / 16; ++T)
#pragma unroll
            for (int i = 0; i < 4; ++i) { const int dist = WIN + t - (16 * T + 4 * qd + i);
                const float s = (unsigned)dist <= (unsigned)WIN ? S[T][i] - slope * (float)dist : -1e30f; S[T][i] = s; mx = fmaxf(mx, s); }
        mx = fmaxf(mx, __shfl_xor(mx, 16)); mx = fmaxf(mx, __shfl_xor(mx, 32)); mx = fmaxf(mx, sinkl);
        float lsum = 0.f;
#pragma unroll
        for (int T = 0; T < NKP / 16; ++T)
#pragma unroll
            for (int i = 0; i < 4; ++i) { const float p = S[T][i] > -1e29f ? __builtin_amdgcn_exp2f(S[T][i] - mx) : 0.f; S[T][i] = p; lsum += p; }
        f32x4 O[4];
#pragma unroll
        for (int dt = 0; dt < 4; ++dt) O[dt] = (f32x4){0.f, 0.f, 0.f, 0.f};
#pragma unroll
        for (int st = 0; st < NKP / 32; ++st) {
            u32x4 w; w.x = pk2(S[2 * st][0], S[2 * st][1]); w.y = pk2(S[2 * st][2], S[2 * st][3]); w.z = pk2(S[2 * st + 1][0], S[2 * st + 1][1]); w.w = pk2(S[2 * st + 1][2], S[2 * st + 1][3]);
            const bf16x8 pf = __builtin_bit_cast(bf16x8, w);
#pragma unroll
            for (int dt = 0; dt < 4; ++dt) { const u32x2 lo = *(const LAS u32x2*)(Vt + (dt * 16 + r) * VST + 32 * st + 4 * qd), hi = *(const LAS u32x2*)(Vt + (dt * 16 + r) * VST + 32 * st + 16 + 4 * qd);
                O[dt] = __builtin_amdgcn_mfma_f32_16x16x32_bf16(__builtin_bit_cast(bf16x8, (u32x4){lo.x, lo.y, hi.x, hi.y}), pf, O[dt], 0, 0, 0); }
        }
        lsum += __shfl_xor(lsum, 16); lsum += __shfl_xor(lsum, 32);
        const float inv = __builtin_amdgcn_rcpf(lsum + __builtin_amdgcn_exp2f(sinkl - mx));
        bf16_t* op = (bf16_t*)(a.ws + WS_B) + (zrow0 + t) * 512 + h * 64 + 4 * qd;
#pragma unroll
        for (int dt = 0; dt < 4; ++dt) { u32x2 w; w.x = pk2(O[dt][0] * inv, O[dt][1] * inv); w.y = pk2(O[dt][2] * inv, O[dt][3] * inv); *(u32x2*)(op + dt * 16) = w; }
    }
    __syncthreads();
}

struct SsmTab { f32x4 ta; bf16x8 af[8]; bf16x8 cf[4]; float dsk; };
template <bool PASS_B> __device__ __forceinline__ void ssm_tables(const Args& a, int l, int gq, int wave, SsmTab& T) {
    const int lane = opq(threadIdx.x) & 63, r = lane & 15, qd = lane >> 4, g = gq * 8 + wave;
    T.ta = ((const f32x4*)(a.ws + WS_TA))[(l * NG + g) * NP + lane];
    const bf16_t* tbh = (const bf16_t*)(a.ws + WS_TB) + (size_t)(l * NG + g) * 128 * GC + r * GC + 8 * (qd & 1);
#pragma unroll
    for (int pt = 0; pt < 8; ++pt) { const bf16x8 v = *(const bf16x8*)(tbh + pt * 16 * GC); T.af[pt] = qd < 2 ? v : (bf16x8){0, 0, 0, 0, 0, 0, 0, 0}; }
    T.dsk = 0.f;
    if (PASS_B) { const bf16_t* tc = (const bf16_t*)(a.ws + WS_TC) + (size_t)(l * NG + g) * GC * 128 + r * 128 + qd * 8;
#pragma unroll
        for (int s = 0; s < 4; ++s) T.cf[s] = *(const bf16x8*)(tc + s * 32);
        T.dsk = a.in[I_DSK][l * 512 + g * 16 + r]; }
}
__device__ __forceinline__ void ssm_stage_load(const Args& a, size_t row0, int ntok, int gq, u32x4 (&pre)[2]) {
    const int tid = opq(threadIdx.x); const bf16_t* Z = (const bf16_t*)(a.ws + WS_C);
#pragma unroll
    for (int k = 0; k < 2; ++k) { const int idx = tid + 512 * k, t = idx >> 4, c8 = idx & 15; if (idx < ntok * 16) pre[k] = *(const u32x4*)(Z + (row0 + t) * INC + ZU + gq * 128 + c8 * 8); }
}
template <bool PASS_B> __device__ __forceinline__ void ssm_unit(const Args& a, LAS unsigned char* lds, const SsmTab& T, const u32x4 (&pre)[2], int l, size_t row0, int ntok, int gq, float& hr_io, float& hi_io, int wave) {
    const int tid = opq(threadIdx.x), lane = tid & 63, r = lane & 15, qd = lane >> 4;
    constexpr int UST = 136, XST = 132, HST = 136;
    LAS bf16_t* Ub = (LAS bf16_t*)lds;
    LAS float* Xs = (LAS float*)(lds + 64 * UST * 2) + wave * (16 * XST);
    LAS bf16_t* hb = (LAS bf16_t*)(lds + 64 * UST * 2 + 8 * 16 * XST * 4) + wave * (16 * HST);
    const int g = gq * 8 + wave;
    const f32x4 ta = T.ta; const float ar = ta[0], ai = ta[1], dsk = T.dsk;
    float hr = hr_io, hi = hi_io;
#pragma unroll
    for (int k = 0; k < 2; ++k) { const int idx = tid + 512 * k, t = idx >> 4, c8 = idx & 15; if (idx < ntok * 16) *(LAS u32x4*)(Ub + t * UST + c8 * 8) = pre[k]; }
    __syncthreads();
#pragma unroll 1
    for (int t0 = 0; t0 < ntok; t0 += 16) {
        const int nt = (ntok - t0) < 16 ? (ntok - t0) : 16;
        {
            const bf16x8 uv = *(const LAS bf16x8*)(Ub + (t0 + r) * UST + wave * 16 + 8 * (qd & 1)); const bf16x8 ub = qd < 2 ? uv : (bf16x8){0, 0, 0, 0, 0, 0, 0, 0};
#pragma unroll
            for (int pt = 0; pt < 8; ++pt) { const f32x4 x = __builtin_amdgcn_mfma_f32_16x16x32_bf16(T.af[pt], ub, (f32x4){0.f, 0.f, 0.f, 0.f}, 0, 0, 0); *(LAS f32x4*)(Xs + r * XST + pt * 16 + 4 * qd) = x; }
        }
        asm volatile("s_waitcnt lgkmcnt(0)" ::: "memory");
        {
            typedef float f32x2 __attribute__((ext_vector_type(2)));
            f32x2 xv[16];
#pragma unroll
            for (int tt = 0; tt < 16; ++tt) xv[tt] = *(const LAS f32x2*)(Xs + tt * XST + 2 * lane);
            f32x2 h = {hr, hi}; const f32x2 a1 = {ar, ar}, a2 = {-ai, ai};
            if (nt == 16) {
#pragma unroll
                for (int tt = 0; tt < 16; ++tt) { const f32x2 hs = {h.y, h.x}; h = a1 * h + (a2 * hs + xv[tt]);
                    if (PASS_B) *(LAS unsigned*)(hb + tt * HST + 2 * lane) = pk2(h.x, h.y); }
            } else {
#pragma unroll
                for (int tt = 0; tt < 16; ++tt) if (tt < nt) { const f32x2 hs = {h.y, h.x}; h = a1 * h + (a2 * hs + xv[tt]);
                    if (PASS_B) *(LAS unsigned*)(hb + tt * HST + 2 * lane) = pk2(h.x, h.y); }
            }
            hr = h.x; hi = h.y;
        }
        if (PASS_B) {
            f32x4 acc = {0.f, 0.f, 0.f, 0.f};
            asm volatile("s_waitcnt lgkmcnt(0)" ::: "memory");
#pragma unroll
            for (int s = 0; s < 4; ++s) { const bf16x8 hf = *(const LAS bf16x8*)(hb + r * HST + s * 32 + qd * 8); acc = __builtin_amdgcn_mfma_f32_16x16x32_bf16(hf, T.cf[s], acc, 0, 0, 0); }
            asm volatile("s_waitcnt lgkmcnt(0)" ::: "memory");
            bf16_t* yo = (bf16_t*)(a.ws + WS_B + HALFROWS);
#pragma unroll
            for (int k = 0; k < 4; ++k) { const int tt = 4 * qd + k;
                if (tt < nt) { const float y = acc[k] + dsk * bf2f(Ub[(t0 + tt) * UST + wave * 16 + r]); yo[(row0 + t0 + tt) * 512 + g * 16 + r] = f2bf(gelu_tanh(y)); } }
        }
        asm volatile("s_waitcnt lgkmcnt(0)" ::: "memory");
    }
    hr_io = hr; hi_io = hi;
    __syncthreads();
}

#define XB_TMO      128
#define XB_XCNT(j)  (256  + 64 * (j))
#define XB_XSUB(j)  (1280 + 64 * (j))
#define XB_XGEN(j)  (2304 + 64 * (j))
#define XB_TOP      3328
#define XB_TOPGEN   3392
#define XCD_BAR_WORDS 3456
#define XB_SPIN_CAP (1u << 18)

__device__ __forceinline__ unsigned xb_ld(unsigned* p)              { return __hip_atomic_load(p, __ATOMIC_RELAXED, __HIP_MEMORY_SCOPE_AGENT); }
__device__ __forceinline__ unsigned xb_add(unsigned* p, unsigned v) { return __hip_atomic_fetch_add(p, v, __ATOMIC_RELAXED, __HIP_MEMORY_SCOPE_AGENT); }
__device__ __forceinline__ unsigned xb_xcc_id() { return (unsigned)__builtin_amdgcn_s_getreg((3 << 11) | 20) & 0xFu; }
#define XB_SPIN(cond, bar) do { unsigned _sp = 0; while (cond) { __builtin_amdgcn_s_sleep(1); \
    if ((++_sp & 255u) == 0u) { if (xb_ld(&(bar)[XB_TMO])) break; if (_sp > XB_SPIN_CAP) { atomicAdd(&(bar)[XB_TMO], 1u); break; } } } } while (0)

struct XcdBarrier {
    unsigned* bar; unsigned x;
    volatile LAS unsigned* st;
};

__device__ __forceinline__ XcdBarrier xcd_barrier_post(unsigned* bar, volatile LAS unsigned* st) {
    XcdBarrier b; b.bar = bar; b.x = xb_xcc_id(); b.st = st;
    if (threadIdx.x == 0) (void)xb_add(&bar[XB_XCNT(b.x)], 1u);
    return b;
}
__device__ __forceinline__ void xcd_barrier_complete(unsigned* bar, unsigned x, unsigned& nloc, unsigned& nx) {
    const unsigned G = gridDim.x * gridDim.y * gridDim.z;
    unsigned sum, cnt, mine, sp = 0u;
    for (;;) {
        sum = 0u; cnt = 0u; mine = 0u;
#pragma unroll
        for (unsigned j = 0; j < 16; ++j) { const unsigned c = xb_ld(&bar[XB_XCNT(j)]); sum += c; cnt += (c > 0u) ? 1u : 0u; mine = (j == x) ? c : mine; }
        if (sum == G) break;
        __builtin_amdgcn_s_sleep(1);
        if ((++sp & 255u) == 0u) { if (xb_ld(&bar[XB_TMO])) break; if (sp > XB_SPIN_CAP) { atomicAdd(&bar[XB_TMO], 1u); break; } }
    }
    nloc = mine > 0u ? mine : 1u; nx = cnt > 0u ? cnt : 1u;
}

__device__ __forceinline__ void xcd_barrier(const XcdBarrier& b) {
    asm volatile("s_waitcnt vmcnt(0)" ::: "memory");
    __syncthreads();
    if (threadIdx.x == 0) {
        unsigned* bar = b.bar;
        __builtin_amdgcn_s_waitcnt(0);
        unsigned nloc = b.st[0], nx = b.st[1];
        if (nloc == 0u) { xcd_barrier_complete(bar, b.x, nloc, nx); b.st[0] = nloc; b.st[1] = nx; }
        const unsigned old = xb_add(&bar[XB_XSUB(b.x)], 1u);
        const unsigned gen = old / nloc;
        if (old + 1u == (gen + 1u) * nloc) {
            __builtin_amdgcn_fence(__ATOMIC_RELEASE, "agent");
            asm volatile("s_waitcnt vmcnt(0)" ::: "memory");
            const unsigned og = xb_add(&bar[XB_TOP], 1u);
            const unsigned tg = og / nx;
            if (og + 1u == (tg + 1u) * nx) xb_add(&bar[XB_TOPGEN], 1u);
            else XB_SPIN(xb_ld(&bar[XB_TOPGEN]) == tg, bar);
            __builtin_amdgcn_fence(__ATOMIC_ACQUIRE, "agent");
            xb_add(&bar[XB_XGEN(b.x)], 1u);
            asm volatile("s_waitcnt vmcnt(0)" ::: "memory");
        } else {
            XB_SPIN(xb_ld(&bar[XB_XGEN(b.x)]) == gen, bar);
            __builtin_amdgcn_fence(__ATOMIC_ACQUIRE, "agent");
            asm volatile("s_waitcnt vmcnt(0)" ::: "memory");
        }
    }
    __syncthreads();
}

__global__ void __launch_bounds__(512, 2) mk_fwd(Args a) {
    extern __shared__ __attribute__((aligned(16))) unsigned char lds_raw[];
    LAS unsigned char* lds = (LAS unsigned char*)lds_raw;
    cg::grid_group grid = cg::this_grid();
    const int tid = threadIdx.x, lane = tid & 63, wave = __builtin_amdgcn_readfirstlane(tid >> 6);
    const int G = gridDim.x, bx = blockIdx.x;
    unsigned char* ws = a.ws;
    float* ss = (float*)(ws + WS_SS);
    bf16_t* bufA = (bf16_t*)(ws + WS_A);
    bf16_t* mixed = (bf16_t*)a.out;
    bf16_t* attn = (bf16_t*)(ws + WS_B); bf16_t* ssmy = (bf16_t*)(ws + WS_B + HALFROWS); bf16_t* xb2 = (bf16_t*)(ws + WS_B);
    bf16_t* Z = (bf16_t*)(ws + WS_C); bf16_t* ssmg = (bf16_t*)(ws + WS_C + ZBYTES); float* Ebuf = (float*)(ws + WS_C + ZBYTES + HALFROWS); bf16_t* H = (bf16_t*)(ws + WS_C);

    unsigned* barw = (unsigned*)(ws + 16384);
    volatile LAS unsigned* bst = (volatile LAS unsigned*)(lds + LDS_BYTES - 64);
    if (bx == 0) for (int i = tid; i < XCD_BAR_WORDS; i += 512) barw[i] = 0u;
    if (tid < 2) bst[tid] = 0u;
    __syncthreads();
    grid.sync();
    { const int t2 = opq(threadIdx.x); prologue(a, lds, t2, wave, t2 & 63); }
    (void)xcd_barrier_post(barw, bst);
#define GRID_BAR() do { XcdBarrier b_; b_.bar = (unsigned*)(a.ws + 16384); b_.x = xb_xcc_id(); b_.st = (volatile LAS unsigned*)(lds + LDS_BYTES - 64); xcd_barrier(b_); } while (0)
    GRID_BAR();
#pragma unroll 1
    for (int l = 0; l < 2; ++l) {
        const bf16_t* Wl = (const bf16_t*)(ws + WS_W) + (size_t)l * W_LAYER;
        float* ss1 = ss + (size_t)(2 * l) * MTOK; float* ss2 = ss + (size_t)(2 * l + 1) * MTOK; float* ss1n = ss + (size_t)(2 * l + 2) * MTOK;
        { pg8::Gemm g{bufA, Wl + W_IN, NTOK_P, INC - 256, DM}; pg8::StaticOrder S; S.init(NTOK_P, INC - 256, G, bx); EpiIn E{Z, ss1, a.in[I_BG] + l * 2048, 0};
          pg8::gemm_phase<EpiIn, pg8::StaticOrder, true, true>(lds, g, S, E);
          skinny_gemm<4>(lds, bufA, Wl + W_IN, INC, DM, E, 0); }
        GRID_BAR();
#ifndef REP_MIX
#define REP_MIX 1
#endif
#pragma unroll 1
        for (int rep = 0; rep < REP_MIX; ++rep) {
#ifndef SKIP_AP
        for (int u = bx; u < 256; u += G) attn_prompt_unit(a, lds, l, u >> 5, (u >> 1) & 15, u & 1, opq(threadIdx.x));
#endif
#ifndef SKIP_AS
        for (int u = bx; u < 2 * DEC_B; u += G) attn_sample_unit(a, lds, l, u >> 1, u & 1, opq(threadIdx.x));
#endif
#ifndef SKIP_SA
        {   SsmTab T; ssm_tables<false>(a, l, bx & 3, wave, T); u32x4 pre[2];
            for (int u = bx; u < NBATCH * (NSEG - 1) * 4; u += G) { const int gq = u & 3, seg = (u >> 2) % (NSEG - 1), b = (u >> 2) / (NSEG - 1);
                const size_t r0 = (size_t)b * SEQ + (size_t)seg * (SEGB * SBLK); float hr = 0.f, hi = 0.f;
                ssm_stage_load(a, r0, SBLK, gq, pre);
#pragma unroll 1
                for (int blk = 0; blk < SEGB; ++blk) { u32x4 cur[2] = {pre[0], pre[1]};
                    if (blk + 1 < SEGB) ssm_stage_load(a, r0 + (blk + 1) * SBLK, SBLK, gq, pre);
                    ssm_unit<false>(a, lds, T, cur, l, r0 + blk * SBLK, SBLK, gq, hr, hi, wave); }
                const int lane = opq(threadIdx.x) & 63, g = gq * 8 + wave;
                *(float2*)(Ebuf + ((((size_t)b * NSEG + seg) * NG + g) * NP + lane) * 2) = make_float2(hr, hi); } }
#endif
        GRID_BAR();
        {   SsmTab T; ssm_tables<true>(a, l, bx & 3, wave, T); u32x4 pre[2];
            for (int u = bx; u < NBATCH * NSEG * 4; u += G) { const int gq = u & 3, seg = (u >> 2) % NSEG, b = (u >> 2) / NSEG;
                const size_t r0 = (size_t)b * SEQ + (size_t)seg * (SEGB * SBLK); const int lane = opq(threadIdx.x) & 63, g = gq * 8 + wave;
                ssm_stage_load(a, r0, SBLK, gq, pre);
                float hr = 0.f, hi = 0.f;
                {
                    float2 e[NSEG - 1];
#pragma unroll
                    for (int i = 0; i < NSEG - 1; ++i) e[i] = (i < seg) ? *(const float2*)(Ebuf + ((((size_t)b * NSEG + i) * NG + g) * NP + lane) * 2) : make_float2(0.f, 0.f);
#pragma unroll
                    for (int i = 0; i < NSEG - 1; ++i) if (i < seg) { const float nr = T.ta[2] * hr - T.ta[3] * hi + e[i].x, ni = T.ta[2] * hi + T.ta[3] * hr + e[i].y; hr = nr; hi = ni; } }
#pragma unroll 1
                for (int blk = 0; blk < SEGB; ++blk) { u32x4 cur[2] = {pre[0], pre[1]};
                    if (blk + 1 < SEGB) ssm_stage_load(a, r0 + (blk + 1) * SBLK, SBLK, gq, pre);
                    ssm_unit<true>(a, lds, T, cur, l, r0 + blk * SBLK, SBLK, gq, hr, hi, wave); }
                if (seg == NSEG - 1) { const size_t so = ((size_t)l * NBATCH + b) * NG * NP + g * NP + lane; a.out[O_HRP + so] = hr; a.out[O_HIP + so] = hi; } }
            for (int v = bx; v < DEC_B * 4; v += G) { const int gq = v & 3, b = v >> 2; const int lane = opq(threadIdx.x) & 63, g = gq * 8 + wave;
                const size_t so = ((size_t)l * DEC_B + b) * NG * NP + g * NP + lane;
                ssm_stage_load(a, (size_t)NTOK_P + b * DEC_T, DEC_T, gq, pre);
                float hr = a.in[I_SR][so], hi = a.in[I_SI][so];
                ssm_unit<true>(a, lds, T, pre, l, (size_t)NTOK_P + b * DEC_T, DEC_T, gq, hr, hi, wave);
                a.out[O_HRS + so] = hr; a.out[O_HIS + so] = hi; } }
        GRID_BAR();
        }
        { pg8::Gemm g{ssmy, Wl + W_GLU, NTOK_P, 512, 512}; pg8::StaticOrder S; S.init(NTOK_P, 512, G, bx); EpiGlu E{ssmy, ssmg, a.in[I_BGLU] + l * 512};
          pg8::gemm_phase<EpiGlu, pg8::StaticOrder, true, true>(lds, g, S, E);
          { pg8::Gemm g1{bufA, Wl + W_IN + (size_t)(INC - 256) * DM, NTOK_P, 256, DM}; pg8::StaticOrder S1; S1.init(NTOK_P, 256, G, (bx + G - 128) % G); EpiIn E1{Z, ss1, a.in[I_BG] + l * 2048, INC / 256 - 1};
            pg8::gemm_phase<EpiIn, pg8::StaticOrder, true, true>(lds, g1, S1, E1); }
          skinny_gemm<2>(lds, ssmy, Wl + W_GLU, 512, 512, E, 192); }
        GRID_BAR();
        { pg8::Gemm g{attn, Wl + W_AO, NTOK_P, DM, 512}; pg8::StaticOrder S; S.init(NTOK_P, DM, G, bx); EpiMix<false> E{Z + ZG, mixed};
          pg8::gemm_phase<EpiMix<false>, pg8::StaticOrder, true, true>(lds, g, S, E);
          skinny_gemm<2>(lds, attn, Wl + W_AO, DM, 512, E, 0); }
        { pg8::Gemm g{ssmg, Wl + W_SO, NTOK_P, DM, 512}; pg8::StaticOrder S; S.init(NTOK_P, DM, G, bx); EpiMix<true> E{Z + ZG + DM, mixed};
          pg8::gemm_phase<EpiMix<true>, pg8::StaticOrder, true, true>(lds, g, S, E);
          skinny_gemm<2>(lds, ssmg, Wl + W_SO, DM, 512, E, 0); }
        GRID_BAR();
        { pg8::Gemm g{mixed, Wl + W_OUT, NTOK_P, DM, DM}; pg8::StaticOrder S; S.init(NTOK_P, DM, G, bx);
          EpiRes E{bufA, xb2, nullptr, ss2};
          pg8::gemm_phase<EpiRes, pg8::StaticOrder, true, true>(lds, g, S, E);
          skinny_gemm<2>(lds, mixed, Wl + W_OUT, DM, DM, E, 0); }
        GRID_BAR();
        { pg8::Gemm g{xb2, Wl + W_UP, NTOK_P, FF, DM}; SlotOrder S; S.init(NTOK_P, FF, G, bx);
          LAS float* rsl = (LAS float*)(lds + 131072 + 1024);
          { const int t_ = opq(threadIdx.x);
            if (t_ < 256) {
#pragma unroll 1
                for (int i = 0; i < 4; ++i) { Unit u_; u_.pm = 0; u_.pn = 0; u_.slot = 0; const bool ok_ = S.next(i, u_); rsl[i * 256 + t_] = ok_ ? rsqrtf(ss2[u_.pm * 256 + t_] * (1.f / DM) + EPS) : 0.f; } }
            __syncthreads(); }
          EpiUp E{H, ss2, rsl};
          pg8::gemm_phase<EpiUp, SlotOrder, true, true>(lds, g, S, E);
          skinny_gemm<4>(lds, xb2, Wl + W_UP, FF, DM, E, 0); }
        GRID_BAR();
        { pg8::Gemm g{H, Wl + W_DN, NTOK_P, DM, FF}; pg8::StaticOrder S; S.init(NTOK_P, DM, G, bx);
          EpiRes E{xb2, l == 0 ? bufA : nullptr, l == 0 ? nullptr : a.out, l == 0 ? ss1n : nullptr};
          pg8::gemm_phase<EpiRes, pg8::StaticOrder, true, true>(lds, g, S, E);
          skinny_gemm<2>(lds, H, Wl + W_DN, DM, FF, E, 0); }
        if (l == 0) GRID_BAR();
    }
}

extern "C" void kernel_launch(void* const* d_in, const int* in_sizes, int n_in, void* d_out, int out_size, void* d_ws, size_t ws_size, hipStream_t stream) {
    static int grid = 0;
    if (grid == 0) {
        if (n_in != 28 || (size_t)out_size != O_END || ws_size < WS_END) { fprintf(stderr, "kernel_launch: unexpected shapes n_in %d out %d ws %zu\n", n_in, out_size, ws_size); grid = -1; return; }
        int dev = 0, cus = 0, per_cu = 0;
        (void)hipGetDevice(&dev);
        (void)hipDeviceGetAttribute(&cus, hipDeviceAttributeMultiprocessorCount, dev);
        (void)hipFuncSetAttribute((const void*)mk_fwd, hipFuncAttributeMaxDynamicSharedMemorySize, LDS_BYTES);
        (void)hipOccupancyMaxActiveBlocksPerMultiprocessor(&per_cu, (const void*)mk_fwd, 512, LDS_BYTES);
        if (per_cu < 1) { fprintf(stderr, "kernel_launch: occupancy query reports %d blocks per CU\n", per_cu); grid = -1; return; }
        grid = cus & ~3;
    }
    if (grid < 0) return;
    Args a{};
    for (int i = 0; i < 28; ++i) a.in[i] = (const float*)d_in[i];
    a.out = (float*)d_out; a.ws = (unsigned char*)d_ws;
    void* args[] = {&a};
    hipError_t e = hipLaunchCooperativeKernel((const void*)mk_fwd, dim3(grid), dim3(512), args, LDS_BYTES, stream);
    if (e != hipSuccess) fprintf(stderr, "cooperative launch failed: %s (grid %d)\n", hipGetErrorString(e), grid);
}
```

```cpp
#include <hip/hip_runtime.h>
#include <hip/hip_cooperative_groups.h>
#include <cstdio>
#include <cstdint>
namespace cg = cooperative_groups;
namespace pg8 {
#define PG8_LAS __attribute__((address_space(3)))
typedef unsigned short bf16_t;
typedef short bf16x8 __attribute__((ext_vector_type(8)));
typedef float f32x4 __attribute__((ext_vector_type(4)));
typedef unsigned u32x4 __attribute__((ext_vector_type(4)));
constexpr int BM = 256, BK = 64, HALF = 128, HTB = HALF * BK * 2  , STAGE_BYTES = 8 * HTB, NXCD = 8, WGM = 8;

__host__ __device__ __forceinline__ int lds_byte(int r, int c) { const int st = (r >> 4) * 2 + (c >> 5), rr = r & 15, cc = c & 31, ob = rr * 64 + cc * 2; return st * 1024 + (ob ^ (((ob >> 9) & 1) << 5)); }
__host__ __device__ __forceinline__ void stage_rc(int b, int& R, int& C) { const int st = b / 1024, sb = b % 1024, swz = sb ^ (((sb >> 9) & 1) << 5); R = (st >> 1) * 16 + swz / 64; C = (st & 1) * 32 + (swz % 64) / 2; }
__host__ __device__ __forceinline__ int perm32(int rho) { const int n = rho >> 4, i = rho & 15; return 8 * (i >> 2) + 4 * n + (i & 3); }

struct Unit { int pm, pn; };
struct Gemm { const bf16_t* A; const bf16_t* Bt; int M, N, K; };

struct StaticOrder {
    int nM, nN, nwg, G, c;
    __host__ __device__ void init(int M, int N, int G_, int c_) { nM = M / BM; nN = N / BM; nwg = nM * nN; G = G_; c = c_; }
    __host__ __device__ bool next(int i, Unit& u) const {
        const long L = (long)i * G + c; if (L >= nwg) return false;
        int wgid = (int)L; { const int q = nwg / NXCD, r = nwg % NXCD, xcd = wgid % NXCD, off = wgid / NXCD; wgid = (xcd < r ? xcd * (q + 1) : r * (q + 1) + (xcd - r) * q) + off; }
        const int nig = WGM * nN, gid = wgid / nig, fm = gid * WGM, gsz = (nM - fm) < WGM ? (nM - fm) : WGM;
        u.pm = fm + ((wgid % nig) % gsz); u.pn = (wgid % nig) / gsz; return true;
    }
    __device__ __forceinline__ void a_ready(const Unit&) const {}
    __device__ __forceinline__ void done(const Unit&) const {}
};
__device__ __forceinline__ unsigned cvt_pk_bf16(float lo, float hi) { unsigned r; asm volatile("v_cvt_pk_bf16_f32 %0, %1, %2" : "=v"(r) : "v"(lo), "v"(hi)); return r; }
typedef float f32x2 __attribute__((ext_vector_type(2)));
template <class Epi, class Sched, bool ALIGN_EPI = false, bool SP2 = false>
__device__ __forceinline__ void gemm_phase(PG8_LAS unsigned char* lds, const Gemm g, const Sched& S, const Epi& E) {
    int tid_ = threadIdx.x; asm volatile("" : "+v"(tid_));
    const int tid = tid_, wid = __builtin_amdgcn_readfirstlane(tid >> 6), lane = tid & 63, wr = wid >> 2, wc = wid & 3, fr = lane & 15, fq = lane >> 4;
    const int K = g.K, nt = K / BK;
    unsigned voffA[2], voffB[2];
#pragma unroll
    for (int i = 0; i < 2; ++i) { int R, C; stage_rc(tid * 16 + i * 8192, R, C); const int Rb = Epi::PERM ? ((R & ~31) + perm32(R & 31)) : R;
        voffA[i] = (unsigned)(R * K + C) * 2u; voffB[i] = (unsigned)(Rb * K + C) * 2u; }
    const size_t kstep = (size_t)(BK * 2);
    const size_t hstep = (size_t)HALF * K * 2;
    const size_t tstep = 2 * hstep;
    const unsigned ldsw = (unsigned)wid * 1024u;
    const int aoff = lds_byte(wr * 64 + fr, fq * 8), boff = lds_byte(wc * 32 + fr, fq * 8);
#define PG8_SA(b, h) (((b) * 2 + (h)) * HTB)
#define PG8_SB(b, h) ((4 + (b) * 2 + (h)) * HTB)
#define PG8_STAGE(bufoff, gbase, voff) do { _Pragma("unroll") for (int _i = 0; _i < 2; ++_i) \
        __builtin_amdgcn_global_load_lds((const unsigned*)((const char*)(gbase) + (voff)[_i]), (PG8_LAS unsigned*)(lds + (bufoff) + ldsw + _i * 8192), 16, 0, 0); } while (0)
#define PG8_LDA(dst, b, h) do { _Pragma("unroll") for (int m = 0; m < 4; ++m) _Pragma("unroll") for (int k = 0; k < 2; ++k) dst[m][k] = *(const PG8_LAS bf16x8*)(lds + PG8_SA(b, h) + aoff + m * 2048 + k * 1024); } while (0)
#define PG8_LDB(dst, b, h) do { _Pragma("unroll") for (int n = 0; n < 2; ++n) _Pragma("unroll") for (int k = 0; k < 2; ++k) dst[n][k] = *(const PG8_LAS bf16x8*)(lds + PG8_SB(b, h) + boff + n * 2048 + k * 1024); } while (0)
#define PG8_MMA(ai, bj, At, Bt) do { __builtin_amdgcn_s_setprio(1); _Pragma("unroll") for (int m = 0; m < 4; ++m) _Pragma("unroll") for (int n = 0; n < 2; ++n) _Pragma("unroll") for (int k = 0; k < 2; ++k) \
        acc[ai][bj][m][n] = __builtin_amdgcn_mfma_f32_16x16x32_bf16(Bt[n][k], At[m][k], acc[ai][bj][m][n], 0, 0, 0); __builtin_amdgcn_s_setprio(0); } while (0)
#define PG8_WAIT_V(n) asm volatile("s_waitcnt vmcnt(" #n ")" ::: "memory")
#define PG8_WAIT_L(n) asm volatile("s_waitcnt lgkmcnt(" #n ")" ::: "memory")
#define PG8_BAR __builtin_amdgcn_s_barrier()
#define PG8_SCHED __builtin_amdgcn_sched_barrier(0)
    Unit cur, nxt; int ui = 0;
    if (!S.next(0, cur)) return;
    f32x4 acc[2][2][4][2];
#pragma unroll
    for (int a = 0; a < 2; ++a)
#pragma unroll
        for (int b = 0; b < 2; ++b)
#pragma unroll
            for (int m = 0; m < 4; ++m)
#pragma unroll
                for (int n = 0; n < 2; ++n) acc[a][b][m][n] = (f32x4){0.f, 0.f, 0.f, 0.f};
    bf16x8 At[4][2], B0[2][2], B1[2][2];
    const char* cA = (const char*)g.A + (size_t)cur.pm * tstep; const char* cB = (const char*)g.Bt + (size_t)cur.pn * tstep;
    S.a_ready(cur);
    if constexpr (SP2) {
        PG8_STAGE(PG8_SB(0, 0), cB, voffB); PG8_STAGE(PG8_SB(0, 1), cB + hstep, voffB); PG8_STAGE(PG8_SA(0, 0), cA, voffA); PG8_STAGE(PG8_SA(0, 1), cA + hstep, voffA);
        if (wr == 1) PG8_BAR;
        PG8_WAIT_V(2); PG8_BAR;
        PG8_STAGE(PG8_SB(1, 0), cB + kstep, voffB); PG8_STAGE(PG8_SA(1, 0), cA + kstep, voffA); PG8_STAGE(PG8_SB(1, 1), cB + hstep + kstep, voffB);
        PG8_WAIT_V(6); PG8_BAR;
    } else {
        PG8_STAGE(PG8_SB(0, 0), cB, voffB); PG8_STAGE(PG8_SA(0, 0), cA, voffA); PG8_STAGE(PG8_SB(0, 1), cB + hstep, voffB); PG8_STAGE(PG8_SA(0, 1), cA + hstep, voffA);
        if (wr == 1) PG8_BAR;
        PG8_WAIT_V(4); PG8_BAR;
        PG8_STAGE(PG8_SB(1, 0), cB + kstep, voffB); PG8_STAGE(PG8_SA(1, 0), cA + kstep, voffA); PG8_STAGE(PG8_SB(1, 1), cB + hstep + kstep, voffB);
        PG8_WAIT_V(6); PG8_BAR;
    }
    for (;;) {
        const bool has_next = S.next(ui + 1, nxt);
        const char* nA = has_next ? (const char*)g.A + (size_t)nxt.pm * tstep : cA; const char* nB = has_next ? (const char*)g.Bt + (size_t)nxt.pn * tstep : cB;
        for (int t = 0; t < nt; t += 2) {
            const bool last = (t == nt - 2);
            const char* a1 = cA + (size_t)(t + 1) * kstep;
            const char* a2 = last ? nA : cA + (size_t)(t + 2) * kstep; const char* b2 = last ? nB : cB + (size_t)(t + 2) * kstep;
            const char* a3 = a2 + kstep; const char* b3 = b2 + kstep;
            if (last && has_next) S.a_ready(nxt);
            if constexpr (SP2) {
            PG8_LDB(B0, 0, 0); PG8_LDB(B1, 0, 1); PG8_SCHED; PG8_LDA(At, 0, 0); PG8_STAGE(PG8_SA(1, 1), a1 + hstep, voffA);
            PG8_WAIT_V(8); PG8_WAIT_L(0); PG8_BAR; PG8_MMA(0, 0, At, B0); PG8_MMA(0, 1, At, B1); PG8_BAR; PG8_SCHED;
            PG8_LDA(At, 0, 1); PG8_STAGE(PG8_SB(0, 0), b2, voffB); PG8_STAGE(PG8_SB(0, 1), b2 + hstep, voffB); PG8_STAGE(PG8_SA(0, 0), a2, voffA);
            PG8_WAIT_V(8); PG8_WAIT_L(0); PG8_BAR; PG8_MMA(1, 0, At, B0); PG8_MMA(1, 1, At, B1); PG8_BAR; PG8_SCHED;
            PG8_LDB(B0, 1, 0); PG8_LDB(B1, 1, 1); PG8_SCHED; PG8_LDA(At, 1, 0); PG8_STAGE(PG8_SA(0, 1), a2 + hstep, voffA);
            PG8_WAIT_V(8); PG8_WAIT_L(0); PG8_BAR; PG8_MMA(0, 0, At, B0); PG8_MMA(0, 1, At, B1); PG8_BAR; PG8_SCHED;
            PG8_LDA(At, 1, 1); PG8_STAGE(PG8_SB(1, 0), b3, voffB); PG8_STAGE(PG8_SB(1, 1), b3 + hstep, voffB); PG8_STAGE(PG8_SA(1, 0), a3, voffA);
            PG8_WAIT_V(8); PG8_WAIT_L(0); PG8_BAR; PG8_MMA(1, 0, At, B0); PG8_MMA(1, 1, At, B1); PG8_BAR; PG8_SCHED;
            } else {
            PG8_LDB(B0, 0, 0); PG8_SCHED; PG8_LDA(At, 0, 0); PG8_STAGE(PG8_SA(1, 1), a1 + hstep, voffA);
            PG8_WAIT_L(8); PG8_BAR; PG8_WAIT_L(0); PG8_MMA(0, 0, At, B0); PG8_BAR; PG8_SCHED;
            PG8_LDB(B1, 0, 1); PG8_STAGE(PG8_SB(0, 0), b2, voffB);
            PG8_BAR; PG8_WAIT_L(0); PG8_MMA(0, 1, At, B1); PG8_BAR;
            PG8_LDA(At, 0, 1); PG8_STAGE(PG8_SA(0, 0), a2, voffA);
            PG8_BAR; PG8_WAIT_L(0); PG8_MMA(1, 0, At, B0); PG8_BAR; PG8_SCHED;
            PG8_STAGE(PG8_SB(0, 1), b2 + hstep, voffB);
            PG8_WAIT_V(6); PG8_BAR; PG8_MMA(1, 1, At, B1); PG8_BAR;
            PG8_LDB(B0, 1, 0); PG8_SCHED; PG8_LDA(At, 1, 0); PG8_STAGE(PG8_SA(0, 1), a2 + hstep, voffA);
            PG8_WAIT_L(8); PG8_BAR; PG8_WAIT_L(0); PG8_MMA(0, 0, At, B0); PG8_BAR; PG8_SCHED;
            PG8_LDB(B1, 1, 1); PG8_STAGE(PG8_SB(1, 0), b3, voffB);
            PG8_BAR; PG8_WAIT_L(0); PG8_MMA(0, 1, At, B1); PG8_BAR;
            PG8_LDA(At, 1, 1); PG8_STAGE(PG8_SA(1, 0), a3, voffA);
            PG8_BAR; PG8_WAIT_L(0); PG8_MMA(1, 0, At, B0); PG8_BAR; PG8_SCHED;
            PG8_STAGE(PG8_SB(1, 1), b3 + hstep, voffB);
            PG8_WAIT_V(6); PG8_BAR; PG8_MMA(1, 1, At, B1); PG8_BAR;
            }
        }
        if constexpr (ALIGN_EPI) { if (wr == 0) PG8_BAR; }
        if constexpr (!Epi::AFTER_DRAIN) { E(acc, cur, wr, wc, fr, fq); S.done(cur); }
        if (!has_next) break;
#pragma unroll
        for (int a = 0; a < 2; ++a)
#pragma unroll
            for (int b = 0; b < 2; ++b)
#pragma unroll
                for (int m = 0; m < 4; ++m)
#pragma unroll
                    for (int n = 0; n < 2; ++n) acc[a][b][m][n] = (f32x4){0.f, 0.f, 0.f, 0.f};
        cur = nxt; cA = nA; cB = nB; ++ui;
        if constexpr (ALIGN_EPI) { if (wr == 1) PG8_BAR; }
    }
    PG8_WAIT_V(0);
    if constexpr (!ALIGN_EPI) { if (wr == 0) PG8_BAR; }
    PG8_BAR;
    if constexpr (Epi::AFTER_DRAIN) { E.fused(acc, cur, wr, wc, fr, fq, lds, wid, lane); S.done(cur); }
#undef PG8_SA
#undef PG8_SB
#undef PG8_STAGE
#undef PG8_LDA
#undef PG8_LDB
#undef PG8_MMA
#undef PG8_WAIT_V
#undef PG8_WAIT_L
#undef PG8_BAR
#undef PG8_SCHED
}
}
using pg8::bf16_t; using pg8::bf16x8; using pg8::f32x4; using pg8::u32x4; using pg8::Unit;
#define LAS __attribute__((address_space(3)))
typedef unsigned u32x2 __attribute__((ext_vector_type(2)));

constexpr int DM = 1024, SEQ = 2048, NBATCH = 8, DEC_B = 128, DEC_T = 4, WIN = 128;
constexpr int NTOK_P = NBATCH * SEQ, NTOK_S = DEC_B * DEC_T, MTOK = NTOK_P + NTOK_S;
constexpr int INC = 3328, FF = 4096, NG = 32, NP = 64, GC = 16;
constexpr int ZQ = 0, ZK = 512, ZV = 640, ZU = 768, ZG = 1280;
constexpr int SBLK = 64, SEGB = 4, NSEG = SEQ / (SBLK * SEGB);
constexpr float EPS = 1e-6f, LOG2E = 1.4426950408889634f;
constexpr size_t MiB = 1u << 20;
constexpr size_t WS_SS = 1 * MiB, WS_TA = 1 * MiB + 512 * 1024, WS_TC = 1 * MiB + 640 * 1024, WS_TB = 2 * MiB;
constexpr size_t WS_W = 3 * MiB, WS_A = 57 * MiB, WS_B = 90 * MiB, WS_C = 123 * MiB, WS_END = 255 * MiB;
constexpr size_t W_IN = 0, W_GLU = W_IN + (size_t)INC * DM, W_AO = W_GLU + 512 * 512, W_SO = W_AO + 1024 * 512, W_OUT = W_SO + 1024 * 512,
                 W_UP = W_OUT + 1024 * 1024, W_DN = W_UP + (size_t)FF * DM, W_LAYER = W_DN + (size_t)FF * DM;
static_assert(WS_W + 2 * W_LAYER * 2 <= WS_A, "weights fit");
constexpr size_t HALFROWS = (size_t)MTOK * 512 * 2;
constexpr size_t ZBYTES = (size_t)MTOK * INC * 2;
static_assert(ZBYTES + HALFROWS + 4 * MiB <= WS_END - WS_C && (size_t)MTOK * FF * 2 <= WS_END - WS_C, "region C");
constexpr size_t O_YP = 0, O_YS = (size_t)NTOK_P * DM, O_KP = O_YS + (size_t)NTOK_S * DM, O_VP = O_KP + 2 * 8 * 128 * 128, O_HRP = O_VP + 2 * 8 * 128 * 128,
                 O_HIP = O_HRP + 2 * 8 * 32 * 64, O_KS = O_HIP + 2 * 8 * 32 * 64, O_VS = O_KS + (size_t)2 * 128 * 128 * 128, O_HRS = O_VS + (size_t)2 * 128 * 128 * 128,
                 O_HIS = O_HRS + 2 * 128 * 32 * 64, O_END = O_HIS + 2 * 128 * 32 * 64;
constexpr int LDS_BYTES = 147456;

__device__ __forceinline__ float bf2f(unsigned short b) { return __uint_as_float(((unsigned)b) << 16); }
__device__ __forceinline__ float bflo(unsigned w) { return __uint_as_float(w << 16); }
__device__ __forceinline__ float bfhi(unsigned w) { return __uint_as_float(w & 0xffff0000u); }
__device__ __forceinline__ unsigned pk2(float lo, float hi) { return pg8::cvt_pk_bf16(lo, hi); }
__device__ __forceinline__ unsigned short f2bf(float f) { return (unsigned short)(pg8::cvt_pk_bf16(f, 0.f) & 0xffffu); }
__device__ __forceinline__ float sigm(float x) { return __builtin_amdgcn_rcpf(1.f + __builtin_amdgcn_exp2f(-LOG2E * x)); }
__device__ __forceinline__ float gelu_tanh(float y) { const float y2 = y * y, t = y * (-2.f * 0.7978845608028654f * LOG2E - (2.f * 0.7978845608028654f * 0.044715f * LOG2E) * y2);
    return y * __builtin_amdgcn_rcpf(1.f + __builtin_amdgcn_exp2f(t)); }
__device__ __forceinline__ void unpack8(const u32x4 w, float (&f)[8]) { f[0] = bflo(w.x); f[1] = bfhi(w.x); f[2] = bflo(w.y); f[3] = bfhi(w.y); f[4] = bflo(w.z); f[5] = bfhi(w.z); f[6] = bflo(w.w); f[7] = bfhi(w.w); }
__device__ __forceinline__ int opq(int v) { asm volatile("" : "+v"(v)); return v; }
__device__ __forceinline__ float wave_sum(float v) {
#pragma unroll
    for (int o = 1; o < 64; o <<= 1) v += __shfl_xor(v, o);
    return v;
}

struct EpiIn {
    static constexpr bool PERM = true, AFTER_DRAIN = false;
    bf16_t* Z; const float* ss; const float* bgate; int pn0;
    struct Pre { float ssv; f32x4 b; };
    __device__ __forceinline__ void prefetch4(int row, int col, Pre& p) const { p.ssv = ss[row]; p.b = col >= ZG ? *(const f32x4*)(bgate + (col - ZG)) : (f32x4){0.f, 0.f, 0.f, 0.f}; }
    __device__ __forceinline__ void apply4(int row, int col, f32x4 v, const Pre& p) const {
        const float rs = rsqrtf(p.ssv * (1.f / DM) + EPS); v = v * rs;
        if (col >= ZG) { const f32x4 b = p.b; v = (f32x4){sigm(v[0] + b[0]), sigm(v[1] + b[1]), sigm(v[2] + b[2]), sigm(v[3] + b[3])}; }
        u32x2 w; w.x = pk2(v[0], v[1]); w.y = pk2(v[2], v[3]); *(u32x2*)(Z + (size_t)row * INC + col) = w;
    }
    __device__ __forceinline__ void operator()(const f32x4 (&acc)[2][2][4][2], const Unit& u, int wr, int wc, int fr, int fq) const {
        const int row0 = u.pm * 256 + wr * 64 + fr, col0 = (u.pn + pn0) * 256 + wc * 32 + 8 * fq; const bool gate = u.pn + pn0 >= 5;
        f32x4 bv[2][2];
#pragma unroll
        for (int bj = 0; bj < 2; ++bj)
#pragma unroll
            for (int n = 0; n < 2; ++n) bv[bj][n] = gate ? *(const f32x4*)(bgate + (col0 - ZG) + bj * 128 + 4 * n) : (f32x4){0.f, 0.f, 0.f, 0.f};
        float rsv[2][4];
#pragma unroll
        for (int ai = 0; ai < 2; ++ai)
#pragma unroll
            for (int m = 0; m < 4; ++m) rsv[ai][m] = ss[row0 + ai * 128 + m * 16];
        __builtin_amdgcn_sched_barrier(0);
#pragma unroll
        for (int ai = 0; ai < 2; ++ai)
#pragma unroll
            for (int m = 0; m < 4; ++m) { const int row = row0 + ai * 128 + m * 16; const float rs = rsqrtf(rsv[ai][m] * (1.f / DM) + EPS); bf16_t* rowp = Z + (size_t)row * INC + col0;
#pragma unroll
                for (int bj = 0; bj < 2; ++bj) { f32x4 v0 = acc[ai][bj][m][0] * rs + bv[bj][0], v1 = acc[ai][bj][m][1] * rs + bv[bj][1];
                    if (gate) { v0 = (f32x4){sigm(v0[0]), sigm(v0[1]), sigm(v0[2]), sigm(v0[3])}; v1 = (f32x4){sigm(v1[0]), sigm(v1[1]), sigm(v1[2]), sigm(v1[3])}; }
                    u32x4 w; w.x = pk2(v0[0], v0[1]); w.y = pk2(v0[2], v0[3]); w.z = pk2(v1[0], v1[1]); w.w = pk2(v1[2], v1[3]);
                    *(u32x4*)(rowp + bj * 128) = w; } }
    }
};
struct EpiGlu {
    static constexpr bool PERM = true, AFTER_DRAIN = false;
    const bf16_t* Y; bf16_t* O; const float* b;
    struct Pre { u32x2 yw; f32x4 bb; };
    __device__ __forceinline__ void prefetch4(int row, int col, Pre& p) const { p.yw = *(const u32x2*)(Y + (size_t)row * 512 + col); p.bb = *(const f32x4*)(b + col); }
    __device__ __forceinline__ void apply4(int row, int col, f32x4 v, const Pre& p) const {
        const u32x2 yw = p.yw; const f32x4 bb = p.bb;
        u32x2 w; w.x = pk2(bflo(yw.x) * sigm(v[0] + bb[0]), bfhi(yw.x) * sigm(v[1] + bb[1])); w.y = pk2(bflo(yw.y) * sigm(v[2] + bb[2]), bfhi(yw.y) * sigm(v[3] + bb[3]));
        *(u32x2*)(O + (size_t)row * 512 + col) = w;
    }
    __device__ __forceinline__ void operator()(const f32x4 (&acc)[2][2][4][2], const Unit& u, int wr, int wc, int fr, int fq) const {
        const int row0 = u.pm * 256 + wr * 64 + fr, col0 = u.pn * 256 + wc * 32 + 8 * fq;
        f32x4 bv[2][2];
#pragma unroll
        for (int bj = 0; bj < 2; ++bj)
#pragma unroll
            for (int n = 0; n < 2; ++n) bv[bj][n] = *(const f32x4*)(b + col0 + bj * 128 + 4 * n);
#pragma unroll
        for (int ai = 0; ai < 2; ++ai) {
            u32x4 yraw[4][2];
#pragma unroll
            for (int m = 0; m < 4; ++m)
#pragma unroll
                for (int bj = 0; bj < 2; ++bj) yraw[m][bj] = *(const u32x4*)(Y + (size_t)(row0 + ai * 128 + m * 16) * 512 + col0 + bj * 128);
            __builtin_amdgcn_sched_barrier(0);
#pragma unroll
            for (int m = 0; m < 4; ++m) { const size_t off = (size_t)(row0 + ai * 128 + m * 16) * 512 + col0;
#pragma unroll
                for (int bj = 0; bj < 2; ++bj) { const f32x4 v0 = acc[ai][bj][m][0] + bv[bj][0], v1 = acc[ai][bj][m][1] + bv[bj][1];
                    float y[8]; unpack8(yraw[m][bj], y);
                    u32x4 w; w.x = pk2(y[0] * sigm(v0[0]), y[1] * sigm(v0[1])); w.y = pk2(y[2] * sigm(v0[2]), y[3] * sigm(v0[3]));
                    w.z = pk2(y[4] * sigm(v1[0]), y[5] * sigm(v1[1])); w.w = pk2(y[6] * sigm(v1[2]), y[7] * sigm(v1[3]));
                    *(u32x4*)(O + off + bj * 128) = w; } } }
    }
};
template <bool SECOND> struct EpiMix {
    static constexpr bool PERM = true, AFTER_DRAIN = false;
    const bf16_t* Zg; bf16_t* O;
    struct Pre { u32x2 gw, pw; };
    __device__ __forceinline__ void prefetch4(int row, int col, Pre& p) const { p.gw = *(const u32x2*)(Zg + (size_t)row * INC + col); if (SECOND) p.pw = *(const u32x2*)(O + (size_t)row * DM + col); }
    __device__ __forceinline__ void apply4(int row, int col, f32x4 v, const Pre& p) const {
        const u32x2 gw = p.gw; bf16_t* op = O + (size_t)row * DM + col;
        v = (f32x4){bflo(gw.x) * v[0], bfhi(gw.x) * v[1], bflo(gw.y) * v[2], bfhi(gw.y) * v[3]};
        if (SECOND) { const u32x2 pw = p.pw; v = v + (f32x4){bflo(pw.x), bfhi(pw.x), bflo(pw.y), bfhi(pw.y)}; }
        u32x2 w; w.x = pk2(v[0], v[1]); w.y = pk2(v[2], v[3]); *(u32x2*)op = w;
    }
    __device__ __forceinline__ void operator()(const f32x4 (&acc)[2][2][4][2], const Unit& u, int wr, int wc, int fr, int fq) const {
        const int row0 = u.pm * 256 + wr * 64 + fr, col0 = u.pn * 256 + wc * 32 + 8 * fq;
#pragma unroll
        for (int ai = 0; ai < 2; ++ai) {
            u32x4 graw[4][2], praw[4][2];
#pragma unroll
            for (int m = 0; m < 4; ++m)
#pragma unroll
                for (int bj = 0; bj < 2; ++bj) { const int row = row0 + ai * 128 + m * 16; graw[m][bj] = *(const u32x4*)(Zg + (size_t)row * INC + col0 + bj * 128);
                    if (SECOND) praw[m][bj] = *(const u32x4*)(O + (size_t)row * DM + col0 + bj * 128); }
            __builtin_amdgcn_sched_barrier(0);
#pragma unroll
            for (int m = 0; m < 4; ++m) { const int row = row0 + ai * 128 + m * 16;
#pragma unroll
                for (int bj = 0; bj < 2; ++bj) { const f32x4 a0 = acc[ai][bj][m][0], a1 = acc[ai][bj][m][1];
                    float g[8]; unpack8(graw[m][bj], g);
                    float v[8] = {g[0] * a0[0], g[1] * a0[1], g[2] * a0[2], g[3] * a0[3], g[4] * a1[0], g[5] * a1[1], g[6] * a1[2], g[7] * a1[3]};
                    bf16_t* op = O + (size_t)row * DM + col0 + bj * 128;
                    if (SECOND) { float p[8]; unpack8(praw[m][bj], p);
#pragma unroll
                        for (int k = 0; k < 8; ++k) v[k] += p[k]; }
                    u32x4 w; w.x = pk2(v[0], v[1]); w.y = pk2(v[2], v[3]); w.z = pk2(v[4], v[5]); w.w = pk2(v[6], v[7]);
                    *(u32x4*)op = w; } } }
    }
};
struct EpiRes {
    static constexpr bool PERM = true, AFTER_DRAIN = false;
    const bf16_t* base; bf16_t* XB; float* Xf; float* ss;
    struct Pre { u32x2 bw; };
    __device__ __forceinline__ void prefetch4(int row, int col, Pre& p) const { p.bw = *(const u32x2*)(base + (size_t)row * DM + col); }
    __device__ __forceinline__ void apply4(int row, int col, f32x4 v, const Pre& p) const {
        const size_t off = (size_t)row * DM + col; const u32x2 bw = p.bw;
        v = v + (f32x4){bflo(bw.x), bfhi(bw.x), bflo(bw.y), bfhi(bw.y)};
        if (Xf) *(f32x4*)(Xf + off) = v;
        if (XB) { u32x2 w; w.x = pk2(v[0], v[1]); w.y = pk2(v[2], v[3]); *(u32x2*)(XB + off) = w; }
        if (ss) { float sq = (v[0] * v[0] + v[1] * v[1]) + (v[2] * v[2] + v[3] * v[3]); sq += __shfl_xor(sq, 1); sq += __shfl_xor(sq, 2); sq += __shfl_xor(sq, 4); if ((threadIdx.x & 7) == 0) atomicAdd(ss + row, sq); }
    }
    __device__ __forceinline__ void operator()(const f32x4 (&acc)[2][2][4][2], const Unit& u, int wr, int wc, int fr, int fq) const {
        const int row0 = u.pm * 256 + wr * 64 + fr, col0 = u.pn * 256 + wc * 32 + 8 * fq;
#pragma unroll
        for (int ai = 0; ai < 2; ++ai) {
            u32x4 braw[4][2];
#pragma unroll
            for (int m = 0; m < 4; ++m)
#pragma unroll
                for (int bj = 0; bj < 2; ++bj) braw[m][bj] = *(const u32x4*)(base + (size_t)(row0 + ai * 128 + m * 16) * DM + col0 + bj * 128);
            __builtin_amdgcn_sched_barrier(0);
#pragma unroll
            for (int m = 0; m < 4; ++m) { const int row = row0 + ai * 128 + m * 16; const size_t off = (size_t)row * DM + col0; float sq = 0.f;
#pragma unroll
                for (int bj = 0; bj < 2; ++bj) { float b[8]; unpack8(braw[m][bj], b);
                    const f32x4 a0 = acc[ai][bj][m][0], a1 = acc[ai][bj][m][1];
                    const f32x4 v0 = (f32x4){b[0] + a0[0], b[1] + a0[1], b[2] + a0[2], b[3] + a0[3]}, v1 = (f32x4){b[4] + a1[0], b[5] + a1[1], b[6] + a1[2], b[7] + a1[3]};
                    sq += (v0[0] * v0[0] + v0[1] * v0[1]) + (v0[2] * v0[2] + v0[3] * v0[3]) + (v1[0] * v1[0] + v1[1] * v1[1]) + (v1[2] * v1[2] + v1[3] * v1[3]);
                    if (Xf) { *(f32x4*)(Xf + off + bj * 128) = v0; *(f32x4*)(Xf + off + bj * 128 + 4) = v1; }
                    if (XB) { u32x4 w; w.x = pk2(v0[0], v0[1]); w.y = pk2(v0[2], v0[3]); w.z = pk2(v1[0], v1[1]); w.w = pk2(v1[2], v1[3]); *(u32x4*)(XB + off + bj * 128) = w; } }
                if (ss) { sq += __shfl_xor(sq, 16); sq += __shfl_xor(sq, 32); if (fq == 0) atomicAdd(ss + row, sq); } } }
    }
};
struct EpiUp {
    static constexpr bool PERM = true, AFTER_DRAIN = false;
    bf16_t* H; const float* ss;
    struct Pre { float ssv; };
    __device__ __forceinline__ void prefetch4(int row, int col, Pre& p) const { p.ssv = ss[row]; }
    __device__ __forceinline__ void apply4(int row, int col, f32x4 v, const Pre& p) const {
        const float rs = rsqrtf(p.ssv * (1.f / DM) + EPS);
#pragma unroll
        for (int k = 0; k < 4; ++k) { const float t = fmaxf(v[k] * rs, 0.f); v[k] = t * t; }
        u32x2 w; w.x = pk2(v[0], v[1]); w.y = pk2(v[2], v[3]); *(u32x2*)(H + (size_t)row * FF + col) = w;
    }
    __device__ __forceinline__ void operator()(const f32x4 (&acc)[2][2][4][2], const Unit& u, int wr, int wc, int fr, int fq) const {
        const int row0 = u.pm * 256 + wr * 64 + fr, col0 = u.pn * 256 + wc * 32 + 8 * fq;
        float rsv[2][4];
#pragma unroll
        for (int ai = 0; ai < 2; ++ai)
#pragma unroll
            for (int m = 0; m < 4; ++m) rsv[ai][m] = ss[row0 + ai * 128 + m * 16];
        __builtin_amdgcn_sched_barrier(0);
#pragma unroll
        for (int ai = 0; ai < 2; ++ai)
#pragma unroll
            for (int m = 0; m < 4; ++m) { const int row = row0 + ai * 128 + m * 16; const float rs = rsqrtf(rsv[ai][m] * (1.f / DM) + EPS); bf16_t* rowp = H + (size_t)row * FF + col0;
#pragma unroll
                for (int bj = 0; bj < 2; ++bj) { f32x4 v0 = acc[ai][bj][m][0] * rs, v1 = acc[ai][bj][m][1] * rs;
#pragma unroll
                    for (int k = 0; k < 4; ++k) { const float a = fmaxf(v0[k], 0.f), b = fmaxf(v1[k], 0.f); v0[k] = a * a; v1[k] = b * b; }
                    u32x4 w; w.x = pk2(v0[0], v0[1]); w.y = pk2(v0[2], v0[3]); w.z = pk2(v1[0], v1[1]); w.w = pk2(v1[2], v1[3]);
                    *(u32x4*)(rowp + bj * 128) = w; } }
    }
};

template <int CT, class Epi> __device__ __forceinline__ void skinny_gemm(LAS unsigned char* lds, const bf16_t* A, const bf16_t* Bt, int N, int K, const Epi& E, int first) {
    const int tid = opq(threadIdx.x), lane = tid & 63, wave = __builtin_amdgcn_readfirstlane(tid >> 6), r = lane & 15, qd = lane >> 4;
    const int G = gridDim.x, nunits = 8 * (N / (16 * CT)), kw = K / 8, nsteps = kw / 32;
    LAS float* red = (LAS float*)lds;
    for (int u = (int)((blockIdx.x + G - first % G) % G); u < nunits; u += G) {
        const int mt = u & 7, nt = u >> 3;
        const bf16_t* ap = A + (size_t)(NTOK_P + mt * 64 + r) * K + wave * kw + 8 * qd;
        const bf16_t* bp = Bt + (size_t)(nt * 16 * CT + r) * K + wave * kw + 8 * qd;
        typename Epi::Pre pre[CT / 2];
#pragma unroll
        for (int e = 0; e < CT / 2; ++e) { const int idx = tid + e * 512; E.prefetch4(NTOK_P + mt * 64 + idx / (4 * CT), nt * 16 * CT + (idx % (4 * CT)) * 4, pre[e]); }
        f32x4 acc[4][CT];
#pragma unroll
        for (int rt = 0; rt < 4; ++rt)
#pragma unroll
            for (int ct = 0; ct < CT; ++ct) acc[rt][ct] = (f32x4){0.f, 0.f, 0.f, 0.f};
#define SKINNY_GROUP(GS, S0) do { bf16x8 af_[GS][4], bf_[GS][CT]; \
            _Pragma("unroll") for (int q_ = 0; q_ < GS; ++q_) { \
                _Pragma("unroll") for (int rt = 0; rt < 4; ++rt) af_[q_][rt] = *(const bf16x8*)(ap + (size_t)rt * 16 * K + ((S0) + q_) * 32); \
                _Pragma("unroll") for (int ct = 0; ct < CT; ++ct) bf_[q_][ct] = *(const bf16x8*)(bp + (size_t)ct * 16 * K + ((S0) + q_) * 32); } \
            __builtin_amdgcn_sched_barrier(0); \
            _Pragma("unroll") for (int q_ = 0; q_ < GS; ++q_) \
                _Pragma("unroll") for (int rt = 0; rt < 4; ++rt) \
                    _Pragma("unroll") for (int ct = 0; ct < CT; ++ct) acc[rt][ct] = __builtin_amdgcn_mfma_f32_16x16x32_bf16(bf_[q_][ct], af_[q_][rt], acc[rt][ct], 0, 0, 0); \
            __builtin_amdgcn_sched_barrier(0); } while (0)
        if (nsteps >= 4) {
#pragma unroll 1
            for (int s0 = 0; s0 < nsteps; s0 += 4) SKINNY_GROUP(4, s0);
        } else SKINNY_GROUP(2, 0);
#undef SKINNY_GROUP
#pragma unroll
        for (int rt = 0; rt < 4; ++rt)
#pragma unroll
            for (int ct = 0; ct < CT; ++ct) *(LAS f32x4*)(red + wave * (64 * 16 * CT) + (rt * 16 + r) * (16 * CT) + ct * 16 + 4 * qd) = acc[rt][ct];
        __syncthreads();
#pragma unroll
        for (int e = 0; e < CT / 2; ++e) { const int idx = tid + e * 512, row = idx / (4 * CT), c4 = idx % (4 * CT);
            f32x4 v = *(const LAS f32x4*)(red + row * (16 * CT) + c4 * 4);
#pragma unroll
            for (int w = 1; w < 8; ++w) v = v + *(const LAS f32x4*)(red + w * (64 * 16 * CT) + row * (16 * CT) + c4 * 4);
            E.apply4(NTOK_P + mt * 64 + row, nt * 16 * CT + c4 * 4, v, pre[e]); }
        __syncthreads();
    }
}

struct Args { const float* in[28]; float* out; unsigned char* ws; };
enum { I_XP = 0, I_XS, I_CK, I_CV, I_SR, I_SI, I_N1G, I_WIN, I_BG, I_QG, I_KG, I_SINK, I_LRE, I_LIM, I_LSTEP, I_BRE, I_BIM, I_CRE, I_CIM, I_DSK, I_WGLU, I_BGLU, I_WAO, I_WSO, I_WOUT, I_N2G, I_WUP, I_WDN };

struct TItem { const float* W; const float* gain; bf16_t* WT; int K, N, k0, n0; };
__device__ __forceinline__ TItem titem(const Args& a, int it) {
    constexpr int I0 = (DM / 64) * (INC / 256), I1 = (512 / 64) * (512 / 256), I2 = (512 / 64) * (1024 / 256), I3 = I2, I4 = (DM / 64) * (DM / 256), I5 = (DM / 64) * (FF / 256), I6 = (FF / 64) * (DM / 256);
    constexpr int IL = I0 + I1 + I2 + I3 + I4 + I5 + I6;
    const int l = it / IL; int r = it % IL; bf16_t* Wl = (bf16_t*)(a.ws + WS_W) + (size_t)l * W_LAYER; TItem t;
    if (r < I0) { t.W = a.in[I_WIN] + (size_t)l * DM * INC; t.gain = a.in[I_N1G] + l * DM; t.WT = Wl + W_IN; t.K = DM; t.N = INC; }
    else if ((r -= I0) < I1) { t.W = a.in[I_WGLU] + (size_t)l * 512 * 512; t.gain = nullptr; t.WT = Wl + W_GLU; t.K = 512; t.N = 512; }
    else if ((r -= I1) < I2) { t.W = a.in[I_WAO] + (size_t)l * 512 * 1024; t.gain = nullptr; t.WT = Wl + W_AO; t.K = 512; t.N = 1024; }
    else if ((r -= I2) < I3) { t.W = a.in[I_WSO] + (size_t)l * 512 * 1024; t.gain = nullptr; t.WT = Wl + W_SO; t.K = 512; t.N = 1024; }
    else if ((r -= I3) < I4) { t.W = a.in[I_WOUT] + (size_t)l * DM * DM; t.gain = nullptr; t.WT = Wl + W_OUT; t.K = DM; t.N = DM; }
    else if ((r -= I4) < I5) { t.W = a.in[I_WUP] + (size_t)l * DM * FF; t.gain = a.in[I_N2G] + l * DM; t.WT = Wl + W_UP; t.K = DM; t.N = FF; }
    else { r -= I5; t.W = a.in[I_WDN] + (size_t)l * FF * DM; t.gain = nullptr; t.WT = Wl + W_DN; t.K = FF; t.N = DM; }
    const int nblk = t.N / 256; t.k0 = 64 * (r / nblk); t.n0 = 256 * (r % nblk);
    return t;
}
constexpr int T_ITEMS = 2 * ((DM / 64) * (INC / 256) + (512 / 64) * (512 / 256) + 2 * (512 / 64) * (1024 / 256) + (DM / 64) * (DM / 256) + (DM / 64) * (FF / 256) + (FF / 64) * (DM / 256));
__device__ __forceinline__ void prologue(const Args& a, LAS unsigned char* lds, int tid, int wave, int lane) {
    unsigned char* ws = a.ws;
    const int gw = blockIdx.x * 8 + wave, NGW = gridDim.x * 8;
    {   constexpr int TS = 257; LAS float* tile = (LAS float*)lds;
        f32x4 v[8]; int it = blockIdx.x;
        if (it < T_ITEMS) { const TItem t = titem(a, it);
#pragma unroll
            for (int i = 0; i < 8; ++i) { v[i] = __builtin_nontemporal_load((const f32x4*)(t.W + (size_t)(t.k0 + 8 * wave + i) * t.N + t.n0 + 4 * lane)); if (t.gain) v[i] = v[i] * t.gain[t.k0 + 8 * wave + i]; } }
        for (; it < T_ITEMS; it += gridDim.x) {
            const TItem t = titem(a, it);
#pragma unroll
            for (int i = 0; i < 8; ++i) { LAS float* tp = tile + (8 * wave + i) * TS + 4 * lane; tp[0] = v[i][0]; tp[1] = v[i][1]; tp[2] = v[i][2]; tp[3] = v[i][3]; }
            __syncthreads();
            if (it + (int)gridDim.x < T_ITEMS) { const TItem tn = titem(a, it + gridDim.x);
#pragma unroll
                for (int i = 0; i < 8; ++i) { v[i] = __builtin_nontemporal_load((const f32x4*)(tn.W + (size_t)(tn.k0 + 8 * wave + i) * tn.N + tn.n0 + 4 * lane)); if (tn.gain) v[i] = v[i] * tn.gain[tn.k0 + 8 * wave + i]; } }
#pragma unroll
            for (int j = 0; j < 4; ++j) { const int q = tid + 512 * j, n = q >> 3, c = q & 7; const LAS float* s = tile + (8 * c) * TS + n;
                u32x4 o; o.x = pk2(s[0 * TS], s[1 * TS]); o.y = pk2(s[2 * TS], s[3 * TS]); o.z = pk2(s[4 * TS], s[5 * TS]); o.w = pk2(s[6 * TS], s[7 * TS]);
                *(u32x4*)(t.WT + (size_t)(t.n0 + n) * t.K + t.k0 + 8 * c) = o; }
            __syncthreads();
        }
    }
    float* ss = (float*)(ws + WS_SS); bf16_t* XB = (bf16_t*)(ws + WS_A);
    for (int mi = gw * 8; mi < MTOK; mi += (mi % 8 == 7) ? (NGW - 1) * 8 + 1 : 1) { const int m = mi;
        const float* src = (m < NTOK_P) ? a.in[I_XP] + (size_t)m * DM : a.in[I_XS] + (size_t)(m - NTOK_P) * DM;
        f32x4 v[4]; float s = 0.f;
#pragma unroll
        for (int j = 0; j < 4; ++j) { v[j] = __builtin_nontemporal_load((const f32x4*)src + lane + 64 * j); s += (v[j][0] * v[j][0] + v[j][1] * v[j][1]) + (v[j][2] * v[j][2] + v[j][3] * v[j][3]); }
        s = wave_sum(s);
#pragma unroll
        for (int j = 0; j < 4; ++j) { u32x2 w; w.x = pk2(v[j][0], v[j][1]); w.y = pk2(v[j][2], v[j][3]); *((u32x2*)(XB + (size_t)m * DM) + lane + 64 * j) = w; }
        if (lane == 0) ss[m] = s;
    }
    for (int i = blockIdx.x * 512 + tid; i < 3 * MTOK; i += gridDim.x * 512) ss[MTOK + i] = 0.f;
    for (int i = tid < 16 ? (int)blockIdx.x * 16 + tid : 2 * NG * NP; i < 2 * NG * NP; i += gridDim.x * 16) {
        const int l = i / (NG * NP), g = (i / NP) % NG, p = i % NP;
        const float lre = a.in[I_LRE][i], lim = a.in[I_LIM][i], step = expf(a.in[I_LSTEP][l * NG + g]);
        const float mag = expf(lre * step), ar = mag * cosf(lim * step), ai = mag * sinf(lim * step), den = lre * lre + lim * lim;
        const float cr = ((ar - 1.f) * lre + ai * lim) / den, ci = (ai * lre - (ar - 1.f) * lim) / den;
        float pr = ar, pi = ai;
#pragma unroll
        for (int k = 0; k < 8; ++k) { const float nr = pr * pr - pi * pi, ni = 2.f * pr * pi; pr = nr; pi = ni; }
        ((f32x4*)(ws + WS_TA))[i] = (f32x4){ar, ai, pr, pi};
        bf16_t* tbh = (bf16_t*)(ws + WS_TB) + (size_t)(l * NG + g) * 128 * GC;
        const float* bre = a.in[I_BRE] + (size_t)i * GC; const float* bim = a.in[I_BIM] + (size_t)i * GC;
#pragma unroll
        for (int c = 0; c < GC; c += 2) { const float br0 = bre[c], bi0 = bim[c], br1 = bre[c + 1], bi1 = bim[c + 1];
            *(unsigned*)(tbh + (2 * p) * GC + c) = pk2(cr * br0 - ci * bi0, cr * br1 - ci * bi1); *(unsigned*)(tbh + (2 * p + 1) * GC + c) = pk2(cr * bi0 + ci * br0, cr * bi1 + ci * br1); }
        bf16_t* tc = (bf16_t*)(ws + WS_TC) + (size_t)(l * NG + g) * GC * 128;
        const float* cre = a.in[I_CRE] + (size_t)(l * NG + g) * GC * NP; const float* cim = a.in[I_CIM] + (size_t)(l * NG + g) * GC * NP;
#pragma unroll
        for (int c = 0; c < GC; ++c) *(unsigned*)(tc + c * 128 + 2 * p) = pk2(cre[c * NP + p], -cim[c * NP + p]);
    }
}

__device__ __forceinline__ void attn_prompt_unit(const Args& a, LAS unsigned char* lds, int l, int b, int qb, int kvh, int tid) {
    constexpr int KST = 72, VST = 272;
    LAS bf16_t* Ks = (LAS bf16_t*)lds; LAS bf16_t* Vt = Ks + 256 * KST; LAS float* kmaxs = (LAS float*)(Vt + 64 * VST);
    const bf16_t* Z = (const bf16_t*)(a.ws + WS_C);
    const float* gk = a.in[I_KG] + l * 64; const float* gq = a.in[I_QG] + l * 64;
    const int wave = tid >> 6, lane = tid & 63, r = lane & 15, qd = lane >> 4, g = wave >> 1, qh = wave & 1, h = kvh * 4 + g;
    const size_t qrow0 = (size_t)b * SEQ + qb * WIN + qh * 64;
    u32x4 qraw[4][2];
#pragma unroll
    for (int qt = 0; qt < 4; ++qt) { const bf16_t* zq = Z + (qrow0 + qt * 16 + r) * INC + ZQ + h * 64 + 8 * qd; qraw[qt][0] = *(const u32x4*)zq; qraw[qt][1] = *(const u32x4*)(zq + 32); }
    f32x4 gkv[8], gqv[4];
#pragma unroll
    for (int c = 0; c < 8; ++c) gkv[c] = *(const f32x4*)(gk + (tid & 1) * 32 + 4 * c);
#pragma unroll
    for (int c = 0; c < 4; ++c) gqv[c] = *(const f32x4*)(gq + (c >> 1) * 32 + 8 * qd + 4 * (c & 1));
    {
        const int j = tid >> 1, half = tid & 1, pos = (qb - 1) * WIN + j; const bool valid = pos >= 0;
        float kf[32]; u32x4 vraw[4];
        if (valid) { const bf16_t* zr = Z + (size_t)(b * SEQ + pos) * INC + kvh * 64 + half * 32;
#pragma unroll
            for (int c = 0; c < 4; ++c) { float t8[8]; unpack8(*(const u32x4*)(zr + ZK + c * 8), t8);
#pragma unroll
                for (int k = 0; k < 8; ++k) kf[c * 8 + k] = t8[k];
                vraw[c] = *(const u32x4*)(zr + ZV + c * 8); }
        } else {
#pragma unroll
            for (int k = 0; k < 32; ++k) kf[k] = 0.f;
#pragma unroll
            for (int c = 0; c < 4; ++c) vraw[c] = (u32x4){0u, 0u, 0u, 0u}; }
        float sq = 0.f;
#pragma unroll
        for (int k = 0; k < 32; ++k) sq += kf[k] * kf[k];
        sq += __shfl_xor(sq, 1);
        const float rs = rsqrtf(sq * (1.f / 64.f) + EPS); float n2 = 0.f;
#pragma unroll
        for (int k = 0; k < 32; ++k) { kf[k] = kf[k] * rs * gkv[k >> 2][k & 3]; n2 += kf[k] * kf[k]; }
        n2 += __shfl_xor(n2, 1);
        { float wm = n2;
#pragma unroll
          for (int o = 1; o < 64; o <<= 1) wm = fmaxf(wm, __shfl_xor(wm, o));
          if (lane == 0) kmaxs[wave] = sqrtf(wm); }
#pragma unroll
        for (int c = 0; c < 4; ++c) { u32x4 w; w.x = pk2(kf[8 * c], kf[8 * c + 1]); w.y = pk2(kf[8 * c + 2], kf[8 * c + 3]); w.z = pk2(kf[8 * c + 4], kf[8 * c + 5]); w.w = pk2(kf[8 * c + 6], kf[8 * c + 7]);
            *(LAS u32x4*)(Ks + j * KST + half * 32 + c * 8) = w; }
#pragma unroll
        for (int c = 0; c < 4; ++c) { const unsigned w4[4] = {vraw[c].x, vraw[c].y, vraw[c].z, vraw[c].w};
#pragma unroll
            for (int k = 0; k < 4; ++k) { Vt[(half * 32 + c * 8 + 2 * k) * VST + j] = (bf16_t)(w4[k] & 0xffffu); Vt[(half * 32 + c * 8 + 2 * k + 1) * VST + j] = (bf16_t)(w4[k] >> 16); } }
        if (qb == SEQ / WIN - 1 && j >= WIN) {
            float* ko = a.out + O_KP + ((((size_t)l * NBATCH + b) * WIN + (j - WIN)) * 2 + kvh) * 64 + half * 32;
            float* vo = a.out + O_VP + ((((size_t)l * NBATCH + b) * WIN + (j - WIN)) * 2 + kvh) * 64 + half * 32;
#pragma unroll
            for (int c = 0; c < 8; ++c) *(f32x4*)(ko + 4 * c) = (f32x4){kf[4 * c], kf[4 * c + 1], kf[4 * c + 2], kf[4 * c + 3]};
#pragma unroll
            for (int c = 0; c < 4; ++c) { *(f32x4*)(vo + 8 * c) = (f32x4){bflo(vraw[c].x), bfhi(vraw[c].x), bflo(vraw[c].y), bfhi(vraw[c].y)}; *(f32x4*)(vo + 8 * c + 4) = (f32x4){bflo(vraw[c].z), bfhi(vraw[c].z), bflo(vraw[c].w), bfhi(vraw[c].w)}; }
        }
    }
    __syncthreads();
    float kmax = kmaxs[0];
#pragma unroll
    for (int w = 1; w < 8; ++w) kmax = fmaxf(kmax, kmaxs[w]);
    const float cs = 0.125f * LOG2E, sinkl = a.in[I_SINK][l * 8 + h] * LOG2E, slope = exp2f(-(float)(h + 1)) * LOG2E;
    bf16x8 qf[4][2]; float mref[4];
#pragma unroll
    for (int qt = 0; qt < 4; ++qt) {
        float x[16]; { float t8[8]; unpack8(qraw[qt][0], t8);
#pragma unroll
            for (int k = 0; k < 8; ++k) x[k] = t8[k];
            unpack8(qraw[qt][1], t8);
#pragma unroll
            for (int k = 0; k < 8; ++k) x[8 + k] = t8[k]; }
        float sq = 0.f;
#pragma unroll
        for (int k = 0; k < 16; ++k) sq += x[k] * x[k];
        sq += __shfl_xor(sq, 16); sq += __shfl_xor(sq, 32);
        const float rs = rsqrtf(sq * (1.f / 64.f) + EPS); float n2 = 0.f;
#pragma unroll
        for (int k = 0; k < 16; ++k) { x[k] = x[k] * rs * gqv[k >> 2][k & 3]; n2 += x[k] * x[k]; }
        n2 += __shfl_xor(n2, 16); n2 += __shfl_xor(n2, 32);
        mref[qt] = fmaxf(sinkl, sqrtf(n2) * kmax * cs);
#pragma unroll
        for (int s = 0; s < 2; ++s) { u32x4 w; w.x = pk2(x[8 * s] * cs, x[8 * s + 1] * cs); w.y = pk2(x[8 * s + 2] * cs, x[8 * s + 3] * cs); w.z = pk2(x[8 * s + 4] * cs, x[8 * s + 5] * cs); w.w = pk2(x[8 * s + 6] * cs, x[8 * s + 7] * cs);
            qf[qt][s] = __builtin_bit_cast(bf16x8, w); }
    }
    f32x4 O[4][4]; float lsum[4];
#pragma unroll
    for (int qt = 0; qt < 4; ++qt) { lsum[qt] = 0.f;
#pragma unroll
        for (int dt = 0; dt < 4; ++dt) O[qt][dt] = (f32x4){0.f, 0.f, 0.f, 0.f}; }
    const int base = r - 4 * qd;
#pragma unroll
    for (int qt = 0; qt < 4; ++qt) mref[qt] += slope * (float)base;
#pragma unroll 1
    for (int ks = (qb == 0 ? (4 - 2 * qh) : 0); ks < 6; ++ks) {
        const int J = qh * 64 + ks * 32, base2 = base - 32 * ks; const float sk = slope * (float)(32 * ks);
        bf16x8 kfr[2][2], vfr[4];
#pragma unroll
        for (int T = 0; T < 2; ++T)
#pragma unroll
            for (int s = 0; s < 2; ++s) kfr[T][s] = *(const LAS bf16x8*)(Ks + (J + 16 * T + r) * KST + 32 * s + 8 * qd);
#pragma unroll
        for (int dt = 0; dt < 4; ++dt) { const u32x2 lo = *(const LAS u32x2*)(Vt + (dt * 16 + r) * VST + J + 4 * qd), hi = *(const LAS u32x2*)(Vt + (dt * 16 + r) * VST + J + 16 + 4 * qd);
            vfr[dt] = __builtin_bit_cast(bf16x8, (u32x4){lo.x, lo.y, hi.x, hi.y}); }
#pragma unroll
        for (int qt = 0; qt < 4; ++qt) {
            if (ks * 32 + 31 >= qt * 16 && ks * 32 <= qt * 16 + 143) {
                f32x4 S[2];
#pragma unroll
                for (int T = 0; T < 2; ++T) { S[T] = __builtin_amdgcn_mfma_f32_16x16x32_bf16(kfr[T][0], qf[qt][0], (f32x4){0.f, 0.f, 0.f, 0.f}, 0, 0, 0); S[T] = __builtin_amdgcn_mfma_f32_16x16x32_bf16(kfr[T][1], qf[qt][1], S[T], 0, 0, 0); }
                const float mt = mref[qt] - sk; float p[2][4];
#pragma unroll
                for (int T = 0; T < 2; ++T)
#pragma unroll
                    for (int i = 0; i < 4; ++i) { const int cst = WIN + 16 * qt - 16 * T - i; const unsigned dist = (unsigned)(cst + base2);
                        const float e = __builtin_amdgcn_exp2f((S[T][i] - mt) - slope * (float)cst); p[T][i] = dist <= (unsigned)WIN ? e : 0.f; lsum[qt] += p[T][i]; }
                u32x4 w; w.x = pk2(p[0][0], p[0][1]); w.y = pk2(p[0][2], p[0][3]); w.z = pk2(p[1][0], p[1][1]); w.w = pk2(p[1][2], p[1][3]);
                const bf16x8 pf = __builtin_bit_cast(bf16x8, w);
#pragma unroll
                for (int dt = 0; dt < 4; ++dt) O[qt][dt] = __builtin_amdgcn_mfma_f32_16x16x32_bf16(vfr[dt], pf, O[qt][dt], 0, 0, 0);
            }
        }
    }
#pragma unroll
    for (int qt = 0; qt < 4; ++qt) mref[qt] -= slope * (float)base;
#pragma unroll
    for (int qt = 0; qt < 4; ++qt) {
        float ls = lsum[qt]; ls += __shfl_xor(ls, 16); ls += __shfl_xor(ls, 32);
        const float inv = 1.f / (ls + __builtin_amdgcn_exp2f(sinkl - mref[qt]));
        bf16_t* op = (bf16_t*)(a.ws + WS_B) + (qrow0 + qt * 16 + r) * 512 + h * 64 + 4 * qd;
#pragma unroll
        for (int dt = 0; dt < 4; ++dt) { u32x2 w; w.x = pk2(O[qt][dt][0] * inv, O[qt][dt][1] * inv); w.y = pk2(O[qt][dt][2] * inv, O[qt][dt][3] * inv); *(u32x2*)(op + dt * 16) = w; }
    }
    __syncthreads();
}
__device__ __forceinline__ void attn_sample_unit(const Args& a, LAS unsigned char* lds, int l, int b, int kvh, int tid) {
    constexpr int KST = 72, VST = 176, NKP = 160;
    LAS bf16_t* Ks = (LAS bf16_t*)lds; LAS bf16_t* Vt = Ks + NKP * KST;
    const bf16_t* Z = (const bf16_t*)(a.ws + WS_C);
    const float* gk = a.in[I_KG] + l * 64; const float* gq = a.in[I_QG] + l * 64;
    const float* ck = a.in[I_CK] + ((size_t)l * DEC_B + b) * WIN * 128 + kvh * 64; const float* cv = a.in[I_CV] + ((size_t)l * DEC_B + b) * WIN * 128 + kvh * 64;
    float* ko = a.out + O_KS + ((size_t)l * DEC_B + b) * WIN * 128 + kvh * 64; float* vo = a.out + O_VS + ((size_t)l * DEC_B + b) * WIN * 128 + kvh * 64;
    const size_t zrow0 = (size_t)NTOK_P + b * DEC_T;
    const int lane = tid & 63, r = lane & 15, qd = lane >> 4, t = r >> 2, h = kvh * 4 + (r & 3);
    u32x4 qraw[2];
    { const bf16_t* zq = Z + (zrow0 + t) * INC + ZQ + h * 64 + 8 * qd; qraw[0] = *(const u32x4*)zq; qraw[1] = *(const u32x4*)(zq + 32); }
    {
        f32x4 kv[4], vv[4];
#pragma unroll
        for (int k = 0; k < 4; ++k) { const int idx = tid + 512 * k, row = idx >> 4, c4 = idx & 15; kv[k] = *(const f32x4*)(ck + (size_t)row * 128 + c4 * 4); vv[k] = *(const f32x4*)(cv + (size_t)row * 128 + c4 * 4); }
        for (int i = tid; i < (NKP - WIN - DEC_T) * 64; i += 512) { const int row = WIN + DEC_T + (i >> 6), d = i & 63; Ks[row * KST + d] = 0; Vt[d * VST + row] = 0; }
#pragma unroll
        for (int k = 0; k < 4; ++k) { const int idx = tid + 512 * k, row = idx >> 4, c4 = idx & 15;
            u32x2 w; w.x = pk2(kv[k][0], kv[k][1]); w.y = pk2(kv[k][2], kv[k][3]); *(LAS u32x2*)(Ks + row * KST + c4 * 4) = w;
#pragma unroll
            for (int i = 0; i < 4; ++i) Vt[(c4 * 4 + i) * VST + row] = f2bf(vv[k][i]);
            if (row >= DEC_T) { *(f32x4*)(ko + (size_t)(row - DEC_T) * 128 + c4 * 4) = kv[k]; *(f32x4*)(vo + (size_t)(row - DEC_T) * 128 + c4 * 4) = vv[k]; } }
        if (tid < 256) { const int t2 = tid >> 6, d = tid & 63; const bf16_t* zr = Z + (zrow0 + t2) * INC + kvh * 64 + d;
            const float kr = bf2f(zr[ZK]), vr = bf2f(zr[ZV]); const float sq = wave_sum(kr * kr); const float kn = kr * rsqrtf(sq * (1.f / 64.f) + EPS) * gk[d];
            Ks[(WIN + t2) * KST + d] = f2bf(kn); Vt[d * VST + WIN + t2] = zr[ZV]; ko[(size_t)(WIN - DEC_T + t2) * 128 + d] = kn; vo[(size_t)(WIN - DEC_T + t2) * 128 + d] = vr; }
    }
    __syncthreads();
    if (tid < 64) {
        const float cs = 0.125f * LOG2E, sinkl = a.in[I_SINK][l * 8 + h] * LOG2E, slope = exp2f(-(float)(h + 1)) * LOG2E;
        bf16x8 qf[2];
        {   float x[16]; { float t8[8]; unpack8(qraw[0], t8);
#pragma unroll
                for (int k = 0; k < 8; ++k) x[k] = t8[k];
                unpack8(qraw[1], t8);
#pragma unroll
                for (int k = 0; k < 8; ++k) x[8 + k] = t8[k]; }
            float sq = 0.f;
#pragma unroll
            for (int k = 0; k < 16; ++k) sq += x[k] * x[k];
            sq += __shfl_xor(sq, 16); sq += __shfl_xor(sq, 32);
            const float rs = rsqrtf(sq * (1.f / 64.f) + EPS) * cs;
#pragma unroll
            for (int k = 0; k < 16; ++k) x[k] = x[k] * rs * gq[(k >> 3) * 32 + 8 * qd + (k & 7)];
#pragma unroll
            for (int s = 0; s < 2; ++s) { u32x4 w; w.x = pk2(x[8 * s], x[8 * s + 1]); w.y = pk2(x[8 * s + 2], x[8 * s + 3]); w.z = pk2(x[8 * s + 4], x[8 * s + 5]); w.w = pk2(x[8 * s + 6], x[8 * s + 7]);
                qf[s] = __builtin_bit_cast(bf16x8, w); } }
        f32x4 S[NKP / 16]; float mx = -1e30f;
#pragma unroll
        for (int T = 0; T < NKP / 16; ++T) {
            const bf16x8 k0 = *(const LAS bf16x8*)(Ks + (16 * T + r) * KST + 8 * qd), k1 = *(const LAS bf16x8*)(Ks + (16 * T + r) * KST + 32 + 8 * qd);
            S[T] = __builtin_amdgcn_mfma_f32_16x16x32_bf16(k0, qf[0], (f32x4){0.f, 0.f, 0.f, 0.f}, 0, 0, 0); S[T] = __builtin_amdgcn_mfma_f32_16x16x32_bf16(k1, qf[1], S[T], 0, 0, 0); }
#pragma unroll
        for (int T = 0; T < NKP / 16; ++T)
#pragma unroll
            for (int i = 0; i < 4; ++i) { const int dist = WIN + t - (16 * T + 4 * qd + i);
                const float s = (unsigned)dist <= (unsigned)WIN ? S[T][i] - slope * (float)dist : -1e30f; S[T][i] = s; mx = fmaxf(mx, s); }
        mx = fmaxf(mx, __shfl_xor(mx, 16)); mx = fmaxf(mx, __shfl_xor(mx, 32)); mx = fmaxf(mx, sinkl);
        float lsum = 0.f;
#pragma unroll
        for (int T = 0; T < NKP / 16; ++T)
#pragma unroll
            for (int i = 0; i < 4; ++i) { const float p = S[T][i] > -1e29f ? __builtin_amdgcn_exp2f(S[T][i] - mx) : 0.f; S[T][i] = p; lsum += p; }
        f32x4 O[4];
#pragma unroll
        for (int dt = 0; dt < 4; ++dt) O[dt] = (f32x4){0.f, 0.f, 0.f, 0.f};
#pragma unroll
        for (int st = 0; st < NKP / 32; ++st) {
            u32x4 w; w.x = pk2(S[2 * st][0], S[2 * st][1]); w.y = pk2(S[2 * st][2], S[2 * st][3]); w.z = pk2(S[2 * st + 1][0], S[2 * st + 1][1]); w.w = pk2(S[2 * st + 1][2], S[2 * st + 1][3]);
            const bf16x8 pf = __builtin_bit_cast(bf16x8, w);
#pragma unroll
            for (int dt = 0; dt < 4; ++dt) { const u32x2 lo = *(const LAS u32x2*)(Vt + (dt * 16 + r) * VST + 32 * st + 4 * qd), hi = *(const LAS u32x2*)(Vt + (dt * 16 + r) * VST + 32 * st + 16 + 4 * qd);
                O[dt] = __builtin_amdgcn_mfma_f32_16x16x32_bf16(__builtin_bit_cast(bf16x8, (u32x4){lo.x, lo.y, hi.x, hi.y}), pf, O[dt], 0, 0, 0); }
        }
        lsum += __shfl_xor(lsum, 16); lsum += __shfl_xor(lsum, 32);
        const float inv = __builtin_amdgcn_rcpf(lsum + __builtin_amdgcn_exp2f(sinkl - mx));
        bf16_t* op = (bf16_t*)(a.ws + WS_B) + (zrow0 + t) * 512 + h * 64 + 4 * qd;
#pragma unroll
        for (int dt = 0; dt < 4; ++dt) { u32x2 w; w.x = pk2(O[dt][0] * inv, O[dt][1] * inv); w.y = pk2(O[dt][2] * inv, O[dt][3] * inv); *(u32x2*)(op + dt * 16) = w; }
    }
    __syncthreads();
}

struct SsmTab { f32x4 ta; bf16x8 af[8]; bf16x8 cf[4]; float dsk; };
template <bool PASS_B> __device__ __forceinline__ void ssm_tables(const Args& a, int l, int gq, int wave, SsmTab& T) {
    const int lane = opq(threadIdx.x) & 63, r = lane & 15, qd = lane >> 4, g = gq * 8 + wave;
    T.ta = ((const f32x4*)(a.ws + WS_TA))[(l * NG + g) * NP + lane];
    const bf16_t* tbh = (const bf16_t*)(a.ws + WS_TB) + (size_t)(l * NG + g) * 128 * GC + r * GC + 8 * (qd & 1);
#pragma unroll
    for (int pt = 0; pt < 8; ++pt) { const bf16x8 v = *(const bf16x8*)(tbh + pt * 16 * GC); T.af[pt] = qd < 2 ? v : (bf16x8){0, 0, 0, 0, 0, 0, 0, 0}; }
    T.dsk = 0.f;
    if (PASS_B) { const bf16_t* tc = (const bf16_t*)(a.ws + WS_TC) + (size_t)(l * NG + g) * GC * 128 + r * 128 + qd * 8;
#pragma unroll
        for (int s = 0; s < 4; ++s) T.cf[s] = *(const bf16x8*)(tc + s * 32);
        T.dsk = a.in[I_DSK][l * 512 + g * 16 + r]; }
}
__device__ __forceinline__ void ssm_stage_load(const Args& a, size_t row0, int ntok, int gq, u32x4 (&pre)[2]) {
    const int tid = opq(threadIdx.x); const bf16_t* Z = (const bf16_t*)(a.ws + WS_C);
#pragma unroll
    for (int k = 0; k < 2; ++k) { const int idx = tid + 512 * k, t = idx >> 4, c8 = idx & 15; if (idx < ntok * 16) pre[k] = *(const u32x4*)(Z + (row0 + t) * INC + ZU + gq * 128 + c8 * 8); }
}
template <bool PASS_B> __device__ __forceinline__ void ssm_unit(const Args& a, LAS unsigned char* lds, const SsmTab& T, const u32x4 (&pre)[2], int l, size_t row0, int ntok, int gq, float& hr_io, float& hi_io, int wave) {
    const int tid = opq(threadIdx.x), lane = tid & 63, r = lane & 15, qd = lane >> 4;
    constexpr int UST = 136, XST = 132, HST = 136;
    LAS bf16_t* Ub = (LAS bf16_t*)lds;
    LAS float* Xs = (LAS float*)(lds + 64 * UST * 2) + wave * (16 * XST);
    LAS bf16_t* hb = (LAS bf16_t*)(lds + 64 * UST * 2 + 8 * 16 * XST * 4) + wave * (16 * HST);
    const int g = gq * 8 + wave;
    const f32x4 ta = T.ta; const float ar = ta[0], ai = ta[1], dsk = T.dsk;
    float hr = hr_io, hi = hi_io;
#pragma unroll
    for (int k = 0; k < 2; ++k) { const int idx = tid + 512 * k, t = idx >> 4, c8 = idx & 15; if (idx < ntok * 16) *(LAS u32x4*)(Ub + t * UST + c8 * 8) = pre[k]; }
    __syncthreads();
#pragma unroll 1
    for (int t0 = 0; t0 < ntok; t0 += 16) {
        const int nt = (ntok - t0) < 16 ? (ntok - t0) : 16;
        {
            const bf16x8 uv = *(const LAS bf16x8*)(Ub + (t0 + r) * UST + wave * 16 + 8 * (qd & 1)); const bf16x8 ub = qd < 2 ? uv : (bf16x8){0, 0, 0, 0, 0, 0, 0, 0};
#pragma unroll
            for (int pt = 0; pt < 8; ++pt) { const f32x4 x = __builtin_amdgcn_mfma_f32_16x16x32_bf16(T.af[pt], ub, (f32x4){0.f, 0.f, 0.f, 0.f}, 0, 0, 0); *(LAS f32x4*)(Xs + r * XST + pt * 16 + 4 * qd) = x; }
        }
        asm volatile("s_waitcnt lgkmcnt(0)" ::: "memory");
        {
            typedef float f32x2 __attribute__((ext_vector_type(2)));
            f32x2 xv[16];
#pragma unroll
            for (int tt = 0; tt < 16; ++tt) xv[tt] = *(const LAS f32x2*)(Xs + tt * XST + 2 * lane);
            f32x2 h = {hr, hi}; const f32x2 a1 = {ar, ar}, a2 = {-ai, ai};
            if (nt == 16) {
#pragma unroll
                for (int tt = 0; tt < 16; ++tt) { const f32x2 hs = {h.y, h.x}; h = a1 * h + (a2 * hs + xv[tt]);
                    if (PASS_B) *(LAS unsigned*)(hb + tt * HST + 2 * lane) = pk2(h.x, h.y); }
            } else {
#pragma unroll
                for (int tt = 0; tt < 16; ++tt) if (tt < nt) { const f32x2 hs = {h.y, h.x}; h = a1 * h + (a2 * hs + xv[tt]);
                    if (PASS_B) *(LAS unsigned*)(hb + tt * HST + 2 * lane) = pk2(h.x, h.y); }
            }
            hr = h.x; hi = h.y;
        }
        if (PASS_B) {
            f32x4 acc = {0.f, 0.f, 0.f, 0.f};
            asm volatile("s_waitcnt lgkmcnt(0)" ::: "memory");
#pragma unroll
            for (int s = 0; s < 4; ++s) { const bf16x8 hf = *(const LAS bf16x8*)(hb + r * HST + s * 32 + qd * 8); acc = __builtin_amdgcn_mfma_f32_16x16x32_bf16(hf, T.cf[s], acc, 0, 0, 0); }
            asm volatile("s_waitcnt lgkmcnt(0)" ::: "memory");
            bf16_t* yo = (bf16_t*)(a.ws + WS_B + HALFROWS);
#pragma unroll
            for (int k = 0; k < 4; ++k) { const int tt = 4 * qd + k;
                if (tt < nt) { const float y = acc[k] + dsk * bf2f(Ub[(t0 + tt) * UST + wave * 16 + r]); yo[(row0 + t0 + tt) * 512 + g * 16 + r] = f2bf(gelu_tanh(y)); } }
        }
        asm volatile("s_waitcnt lgkmcnt(0)" ::: "memory");
    }
    hr_io = hr; hi_io = hi;
    __syncthreads();
}

#define XB_TMO      128
#define XB_XCNT(j)  (256  + 64 * (j))
#define XB_XSUB(j)  (1280 + 64 * (j))
#define XB_XGEN(j)  (2304 + 64 * (j))
#define XB_TOP      3328
#define XB_TOPGEN   3392
#define XCD_BAR_WORDS 3456
#define XB_SPIN_CAP (1u << 18)

__device__ __forceinline__ unsigned xb_ld(unsigned* p)              { return __hip_atomic_load(p, __ATOMIC_RELAXED, __HIP_MEMORY_SCOPE_AGENT); }
__device__ __forceinline__ unsigned xb_add(unsigned* p, unsigned v) { return __hip_atomic_fetch_add(p, v, __ATOMIC_RELAXED, __HIP_MEMORY_SCOPE_AGENT); }
__device__ __forceinline__ unsigned xb_xcc_id() { return (unsigned)__builtin_amdgcn_s_getreg((3 << 11) | 20) & 0xFu; }
#define XB_SPIN(cond, bar) do { unsigned _sp = 0; while (cond) { __builtin_amdgcn_s_sleep(1); \
    if ((++_sp & 255u) == 0u) { if (xb_ld(&(bar)[XB_TMO])) break; if (_sp > XB_SPIN_CAP) { atomicAdd(&(bar)[XB_TMO], 1u); break; } } } } while (0)

struct XcdBarrier {
    unsigned* bar; unsigned x;
    volatile LAS unsigned* st;
};

__device__ __forceinline__ XcdBarrier xcd_barrier_post(unsigned* bar, volatile LAS unsigned* st) {
    XcdBarrier b; b.bar = bar; b.x = xb_xcc_id(); b.st = st;
    if (threadIdx.x == 0) (void)xb_add(&bar[XB_XCNT(b.x)], 1u);
    return b;
}
__device__ __forceinline__ void xcd_barrier_complete(unsigned* bar, unsigned x, unsigned& nloc, unsigned& nx) {
    const unsigned G = gridDim.x * gridDim.y * gridDim.z;
    unsigned sum, cnt, mine, sp = 0u;
    for (;;) {
        sum = 0u; cnt = 0u; mine = 0u;
#pragma unroll
        for (unsigned j = 0; j < 16; ++j) { const unsigned c = xb_ld(&bar[XB_XCNT(j)]); sum += c; cnt += (c > 0u) ? 1u : 0u; mine = (j == x) ? c : mine; }
        if (sum == G) break;
        __builtin_amdgcn_s_sleep(1);
        if ((++sp & 255u) == 0u) { if (xb_ld(&bar[XB_TMO])) break; if (sp > XB_SPIN_CAP) { atomicAdd(&bar[XB_TMO], 1u); break; } }
    }
    nloc = mine > 0u ? mine : 1u; nx = cnt > 0u ? cnt : 1u;
}

__device__ __forceinline__ void xcd_barrier(const XcdBarrier& b) {
    asm volatile("s_waitcnt vmcnt(0)" ::: "memory");
    __syncthreads();
    if (threadIdx.x == 0) {
        unsigned* bar = b.bar;
        __builtin_amdgcn_s_waitcnt(0);
        unsigned nloc = b.st[0], nx = b.st[1];
        if (nloc == 0u) { xcd_barrier_complete(bar, b.x, nloc, nx); b.st[0] = nloc; b.st[1] = nx; }
        const unsigned old = xb_add(&bar[XB_XSUB(b.x)], 1u);
        const unsigned gen = old / nloc;
        if (old + 1u == (gen + 1u) * nloc) {
            __builtin_amdgcn_fence(__ATOMIC_RELEASE, "agent");
            asm volatile("s_waitcnt vmcnt(0)" ::: "memory");
            const unsigned og = xb_add(&bar[XB_TOP], 1u);
            const unsigned tg = og / nx;
            if (og + 1u == (tg + 1u) * nx) xb_add(&bar[XB_TOPGEN], 1u);
            else XB_SPIN(xb_ld(&bar[XB_TOPGEN]) == tg, bar);
            __builtin_amdgcn_fence(__ATOMIC_ACQUIRE, "agent");
            xb_add(&bar[XB_XGEN(b.x)], 1u);
            asm volatile("s_waitcnt vmcnt(0)" ::: "memory");
        } else {
            XB_SPIN(xb_ld(&bar[XB_XGEN(b.x)]) == gen, bar);
            __builtin_amdgcn_fence(__ATOMIC_ACQUIRE, "agent");
            asm volatile("s_waitcnt vmcnt(0)" ::: "memory");
        }
    }
    __syncthreads();
}

__global__ void __launch_bounds__(512, 2) mk_fwd(Args a) {
    extern __shared__ __attribute__((aligned(16))) unsigned char lds_raw[];
    LAS unsigned char* lds = (LAS unsigned char*)lds_raw;
    cg::grid_group grid = cg::this_grid();
    const int tid = threadIdx.x, lane = tid & 63, wave = __builtin_amdgcn_readfirstlane(tid >> 6);
    const int G = gridDim.x, bx = blockIdx.x;
    unsigned char* ws = a.ws;
    float* ss = (float*)(ws + WS_SS);
    bf16_t* bufA = (bf16_t*)(ws + WS_A);
    bf16_t* mixed = (bf16_t*)a.out;
    bf16_t* attn = (bf16_t*)(ws + WS_B); bf16_t* ssmy = (bf16_t*)(ws + WS_B + HALFROWS); bf16_t* xb2 = (bf16_t*)(ws + WS_B);
    bf16_t* Z = (bf16_t*)(ws + WS_C); bf16_t* ssmg = (bf16_t*)(ws + WS_C + ZBYTES); float* Ebuf = (float*)(ws + WS_C + ZBYTES + HALFROWS); bf16_t* H = (bf16_t*)(ws + WS_C);

    unsigned* barw = (unsigned*)(ws + 16384);
    volatile LAS unsigned* bst = (volatile LAS unsigned*)(lds + LDS_BYTES - 64);
    if (bx == 0) for (int i = tid; i < XCD_BAR_WORDS; i += 512) barw[i] = 0u;
    if (tid < 2) bst[tid] = 0u;
    __syncthreads();
    grid.sync();
    { const int t2 = opq(threadIdx.x); prologue(a, lds, t2, wave, t2 & 63); }
    (void)xcd_barrier_post(barw, bst);
#define GRID_BAR() do { XcdBarrier b_; b_.bar = (unsigned*)(a.ws + 16384); b_.x = xb_xcc_id(); b_.st = (volatile LAS unsigned*)(lds + LDS_BYTES - 64); xcd_barrier(b_); } while (0)
    GRID_BAR();
#pragma unroll 1
    for (int l = 0; l < 2; ++l) {
        const bf16_t* Wl = (const bf16_t*)(ws + WS_W) + (size_t)l * W_LAYER;
        float* ss1 = ss + (size_t)(2 * l) * MTOK; float* ss2 = ss + (size_t)(2 * l + 1) * MTOK; float* ss1n = ss + (size_t)(2 * l + 2) * MTOK;
        { pg8::Gemm g{bufA, Wl + W_IN, NTOK_P, INC - 256, DM}; pg8::StaticOrder S; S.init(NTOK_P, INC - 256, G, bx); EpiIn E{Z, ss1, a.in[I_BG] + l * 2048, 0};
          pg8::gemm_phase<EpiIn, pg8::StaticOrder, true, true>(lds, g, S, E);
          skinny_gemm<4>(lds, bufA, Wl + W_IN, INC, DM, E, 0); }
        GRID_BAR();
#ifndef REP_MIX
#define REP_MIX 1
#endif
#pragma unroll 1
        for (int rep = 0; rep < REP_MIX; ++rep) {
#ifndef SKIP_AP
        for (int u = bx; u < 256; u += G) attn_prompt_unit(a, lds, l, u >> 5, (u >> 1) & 15, u & 1, opq(threadIdx.x));
#endif
#ifndef SKIP_AS
        for (int u = bx; u < 2 * DEC_B; u += G) attn_sample_unit(a, lds, l, u >> 1, u & 1, opq(threadIdx.x));
#endif
#ifndef SKIP_SA
        {   SsmTab T; ssm_tables<false>(a, l, bx & 3, wave, T); u32x4 pre[2];
            for (int u = bx; u < NBATCH * (NSEG - 1) * 4; u += G) { const int gq = u & 3, seg = (u >> 2) % (NSEG - 1), b = (u >> 2) / (NSEG - 1);
                const size_t r0 = (size_t)b * SEQ + (size_t)seg * (SEGB * SBLK); float hr = 0.f, hi = 0.f;
                ssm_stage_load(a, r0, SBLK, gq, pre);
#pragma unroll 1
                for (int blk = 0; blk < SEGB; ++blk) { u32x4 cur[2] = {pre[0], pre[1]};
                    if (blk + 1 < SEGB) ssm_stage_load(a, r0 + (blk + 1) * SBLK, SBLK, gq, pre);
                    ssm_unit<false>(a, lds, T, cur, l, r0 + blk * SBLK, SBLK, gq, hr, hi, wave); }
                const int lane = opq(threadIdx.x) & 63, g = gq * 8 + wave;
                *(float2*)(Ebuf + ((((size_t)b * NSEG + seg) * NG + g) * NP + lane) * 2) = make_float2(hr, hi); } }
#endif
        GRID_BAR();
        {   SsmTab T; ssm_tables<true>(a, l, bx & 3, wave, T); u32x4 pre[2];
            for (int u = bx; u < NBATCH * NSEG * 4; u += G) { const int gq = u & 3, seg = (u >> 2) % NSEG, b = (u >> 2) / NSEG;
                const size_t r0 = (size_t)b * SEQ + (size_t)seg * (SEGB * SBLK); const int lane = opq(threadIdx.x) & 63, g = gq * 8 + wave;
                ssm_stage_load(a, r0, SBLK, gq, pre);
                float hr = 0.f, hi = 0.f;
                {
                    float2 e[NSEG - 1];
#pragma unroll
                    for (int i = 0; i < NSEG - 1; ++i) e[i] = (i < seg) ? *(const float2*)(Ebuf + ((((size_t)b * NSEG + i) * NG + g) * NP + lane) * 2) : make_float2(0.f, 0.f);
#pragma unroll
                    for (int i = 0; i < NSEG - 1; ++i) if (i < seg) { const float nr = T.ta[2] * hr - T.ta[3] * hi + e[i].x, ni = T.ta[2] * hi + T.ta[3] * hr + e[i].y; hr = nr; hi = ni; } }
#pragma unroll 1
                for (int blk = 0; blk < SEGB; ++blk) { u32x4 cur[2] = {pre[0], pre[1]};
                    if (blk + 1 < SEGB) ssm_stage_load(a, r0 + (blk + 1) * SBLK, SBLK, gq, pre);
                    ssm_unit<true>(a, lds, T, cur, l, r0 + blk * SBLK, SBLK, gq, hr, hi, wave); }
                if (seg == NSEG - 1) { const size_t so = ((size_t)l * NBATCH + b) * NG * NP + g * NP + lane; a.out[O_HRP + so] = hr; a.out[O_HIP + so] = hi; } }
            for (int v = bx; v < DEC_B * 4; v += G) { const int gq = v & 3, b = v >> 2; const int lane = opq(threadIdx.x) & 63, g = gq * 8 + wave;
                const size_t so = ((size_t)l * DEC_B + b) * NG * NP + g * NP + lane;
                ssm_stage_load(a, (size_t)NTOK_P + b * DEC_T, DEC_T, gq, pre);
                float hr = a.in[I_SR][so], hi = a.in[I_SI][so];
                ssm_unit<true>(a, lds, T, pre, l, (size_t)NTOK_P + b * DEC_T, DEC_T, gq, hr, hi, wave);
                a.out[O_HRS + so] = hr; a.out[O_HIS + so] = hi; } }
        GRID_BAR();
        }
        { pg8::Gemm g{ssmy, Wl + W_GLU, NTOK_P, 512, 512}; pg8::StaticOrder S; S.init(NTOK_P, 512, G, bx); EpiGlu E{ssmy, ssmg, a.in[I_BGLU] + l * 512};
          pg8::gemm_phase<EpiGlu, pg8::StaticOrder, true, true>(lds, g, S, E);
          { pg8::Gemm g1{bufA, Wl + W_IN + (size_t)(INC - 256) * DM, NTOK_P, 256, DM}; pg8::StaticOrder S1; S1.init(NTOK_P, 256, G, (bx + G - 128) % G); EpiIn E1{Z, ss1, a.in[I_BG] + l * 2048, INC / 256 - 1};
            pg8::gemm_phase<EpiIn, pg8::StaticOrder, true, true>(lds, g1, S1, E1); }
          skinny_gemm<2>(lds, ssmy, Wl + W_GLU, 512, 512, E, 192); }
        GRID_BAR();
        { pg8::Gemm g{attn, Wl + W_AO, NTOK_P, DM, 512}; pg8::StaticOrder S; S.init(NTOK_P, DM, G, bx); EpiMix<false> E{Z + ZG, mixed};
          pg8::gemm_phase<EpiMix<false>, pg8::StaticOrder, true, true>(lds, g, S, E);
          skinny_gemm<2>(lds, attn, Wl + W_AO, DM, 512, E, 0); }
        { pg8::Gemm g{ssmg, Wl + W_SO, NTOK_P, DM, 512}; pg8::StaticOrder S; S.init(NTOK_P, DM, G, bx); EpiMix<true> E{Z + ZG + DM, mixed};
          pg8::gemm_phase<EpiMix<true>, pg8::StaticOrder, true, true>(lds, g, S, E);
          skinny_gemm<2>(lds, ssmg, Wl + W_SO, DM, 512, E, 0); }
        GRID_BAR();
        { pg8::Gemm g{mixed, Wl + W_OUT, NTOK_P, DM, DM}; pg8::StaticOrder S; S.init(NTOK_P, DM, G, bx);
          EpiRes E{bufA, xb2, nullptr, ss2};
          pg8::gemm_phase<EpiRes, pg8::StaticOrder, true, true>(lds, g, S, E);
          skinny_gemm<2>(lds, mixed, Wl + W_OUT, DM, DM, E, 0); }
        GRID_BAR();
        { pg8::Gemm g{xb2, Wl + W_UP, NTOK_P, FF, DM}; pg8::StaticOrder S; S.init(NTOK_P, FF, G, bx); EpiUp E{H, ss2};
          pg8::gemm_phase<EpiUp, pg8::StaticOrder, true, true>(lds, g, S, E);
          skinny_gemm<4>(lds, xb2, Wl + W_UP, FF, DM, E, 0); }
        GRID_BAR();
        { pg8::Gemm g{H, Wl + W_DN, NTOK_P, DM, FF}; pg8::StaticOrder S; S.init(NTOK_P, DM, G, bx);
          EpiRes E{xb2, l == 0 ? bufA : nullptr, l == 0 ? nullptr : a.out, l == 0 ? ss1n : nullptr};
          pg8::gemm_phase<EpiRes, pg8::StaticOrder, true, true>(lds, g, S, E);
          skinny_gemm<2>(lds, H, Wl + W_DN, DM, FF, E, 0); }
        if (l == 0) GRID_BAR();
    }
}

extern "C" void kernel_launch(void* const* d_in, const int* in_sizes, int n_in, void* d_out, int out_size, void* d_ws, size_t ws_size, hipStream_t stream) {
    static int grid = 0;
    if (grid == 0) {
        if (n_in != 28 || (size_t)out_size != O_END || ws_size < WS_END) { fprintf(stderr, "kernel_launch: unexpected shapes n_in %d out %d ws %zu\n", n_in, out_size, ws_size); grid = -1; return; }
        int dev = 0, cus = 0, per_cu = 0;
        (void)hipGetDevice(&dev);
        (void)hipDeviceGetAttribute(&cus, hipDeviceAttributeMultiprocessorCount, dev);
        (void)hipFuncSetAttribute((const void*)mk_fwd, hipFuncAttributeMaxDynamicSharedMemorySize, LDS_BYTES);
        (void)hipOccupancyMaxActiveBlocksPerMultiprocessor(&per_cu, (const void*)mk_fwd, 512, LDS_BYTES);
        if (per_cu < 1) { fprintf(stderr, "kernel_launch: occupancy query reports %d blocks per CU\n", per_cu); grid = -1; return; }
        grid = cus & ~3;
    }
    if (grid < 0) return;
    Args a{};
    for (int i = 0; i < 28; ++i) a.in[i] = (const float*)d_in[i];
    a.out = (float*)d_out; a.ws = (unsigned char*)d_ws;
    void* args[] = {&a};
    hipError_t e = hipLaunchCooperativeKernel((const void*)mk_fwd, dim3(grid), dim3(512), args, LDS_BYTES, stream);
    if (e != hipSuccess) fprintf(stderr, "cooperative launch failed: %s (grid %d)\n", hipGetErrorString(e), grid);
}
```
